# Optimizing an MI355X kernel written in HIP

```python
import jax, jax.numpy as jnp
from jax import lax
import numpy as np

D_MODEL = 1024
BATCH = 8
SEQ = 8192
DEPTH = 4
DEC_BATCH = 16
DEC_SEQ = 2048
PAST_LEN = 128

N_MEM = 256
POOL_WINDOWS = (2, 4, 8, 16)
POOL_GROUPS = len(POOL_WINDOWS)
POOL_WIDTH = D_MODEL // 2
POOL_GROUP_W = POOL_WIDTH // POOL_GROUPS
MLA_HEADS = 8
QK_NOPE = 64
QK_ROPE = 32
V_HEAD = 64
Q_LORA = 384
KV_LORA = 256
MLA_WIDTH = MLA_HEADS * V_HEAD
ROPE_THETA = 10000.0
Q_BLOCK = 128
X_HEADS = 4
X_HEAD_DIM = 128
X_WIDTH = X_HEADS * X_HEAD_DIM
N_BRANCH = 3
BRANCH_WIDTH = 512
IN_SPLITS = (POOL_WIDTH, Q_LORA, KV_LORA, QK_ROPE, X_WIDTH)
IN_WIDTH = sum(IN_SPLITS)
IN_OFFSETS = tuple(int(v) for v in np.cumsum(IN_SPLITS)[:-1])
D_FF = -(-8 * D_MODEL // (3 * 256)) * 256
EPS = 1e-6

kernel_name = 'hybrid_pool_mla_memory_encoder'


def rmsnorm(x, g):
    xf = x.astype(jnp.float32)
    y = xf * lax.rsqrt(jnp.mean(xf * xf, axis=-1, keepdims=True) + EPS)
    return (y * g.astype(jnp.float32)).astype(x.dtype)


def rope_tables(seq, dtype):
    inv = 1.0 / (ROPE_THETA ** (np.arange(0, QK_ROPE, 2, dtype=np.float32) / QK_ROPE))
    ang = np.arange(seq, dtype=np.float32)[:, None] * inv[None, :]
    return jnp.asarray(np.cos(ang), dtype), jnp.asarray(np.sin(ang), dtype)


def apply_rope(x, cos, sin):
    half = x.shape[-1] // 2
    x1, x2 = x[..., :half], x[..., half:]
    return jnp.concatenate([x1 * cos - x2 * sin, x2 * cos + x1 * sin], axis=-1)


def multiscale_pool(u, mix, scale):
    B, S, _ = u.shape
    ug = u.reshape(B, S, POOL_GROUPS, POOL_GROUP_W)
    uf = ug.astype(jnp.float32)
    c = jnp.pad(jnp.cumsum(uf, axis=1), ((0, 0), (1, 0), (0, 0), (0, 0)))
    t = np.arange(S)
    pooled = []
    for gi, w in enumerate(POOL_WINDOWS):
        lo = np.clip(t - w // 2, 0, S)
        hi = np.clip(t + w // 2, 0, S)
        cnt = (hi - lo).astype(np.float32)[None, :, None]
        cg = c[:, :, gi]
        pooled.append((cg[:, hi] - cg[:, lo]) / cnt)
    pooled = jnp.stack(pooled, axis=2)
    diff = (pooled - uf).astype(u.dtype)
    y = jnp.einsum('bsgc,gcd->bsgd', diff, mix).reshape(B, S, POOL_WIDTH)
    return y * scale


def latent_attention(cq, ckv, kr, q_norm, kv_norm, w_uq, w_uk, w_uv, cos, sin):
    B, S, _ = cq.shape
    q = (rmsnorm(cq, q_norm) @ w_uq).reshape(B, S, MLA_HEADS, QK_NOPE + QK_ROPE)
    qn = q[..., :QK_NOPE]
    qr = apply_rope(q[..., QK_NOPE:], cos[:, None, :], sin[:, None, :])
    c = rmsnorm(ckv, kv_norm)
    kn = (c @ w_uk).reshape(B, S, MLA_HEADS, QK_NOPE)
    v = (c @ w_uv).reshape(B, S, MLA_HEADS, V_HEAD)
    kr = apply_rope(kr, cos, sin)
    scale = (QK_NOPE + QK_ROPE) ** -0.5
    nb = S // Q_BLOCK
    qn_b = qn.reshape(B, nb, Q_BLOCK, MLA_HEADS, QK_NOPE).transpose(1, 0, 2, 3, 4)
    qr_b = qr.reshape(B, nb, Q_BLOCK, MLA_HEADS, QK_ROPE).transpose(1, 0, 2, 3, 4)

    def block(args):
        qnb, qrb = args
        s = jnp.einsum('bqhd,bkhd->bhqk', qnb, kn) + jnp.einsum('bqhr,bkr->bhqk', qrb, kr)
        p = jax.nn.softmax(s.astype(jnp.float32) * scale, axis=-1).astype(v.dtype)
        return jnp.einsum('bhqk,bkhd->bqhd', p, v)

    o = lax.map(block, (qn_b, qr_b))
    return o.transpose(1, 0, 2, 3, 4).reshape(B, S, MLA_WIDTH)


def memory_attention(qx, mem_n, w_mem_kv):
    B, S, _ = qx.shape
    q = qx.reshape(B, S, X_HEADS, X_HEAD_DIM)
    kv = mem_n @ w_mem_kv
    k = kv[..., :X_WIDTH].reshape(B, -1, X_HEADS, X_HEAD_DIM)
    v = kv[..., X_WIDTH:].reshape(B, -1, X_HEADS, X_HEAD_DIM)
    s = jnp.einsum('bshd,bmhd->bhsm', q, k)
    p = jax.nn.softmax(s.astype(jnp.float32) * (X_HEAD_DIM ** -0.5), axis=-1).astype(v.dtype)
    return jnp.einsum('bhsm,bmhd->bshd', p, v).reshape(B, S, X_WIDTH)


def encoder_layer(x, mem, cos, sin, w_in, q_norm, kv_norm, w_uq, w_uk, w_uv, pool_mix, pool_scale,
                  mem_norm, w_mem_kv, w_branch, w_gate, b_gate, w_out,
                  ln_mix_pre, ln_mix_post, ln_ffn_pre, ln_ffn_post, w_gu, w_down):
    B, S, D = x.shape
    h = rmsnorm(x, ln_mix_pre)
    z = h @ w_in
    u_pool, cq, ckv, kr, qx = jnp.split(z, IN_OFFSETS, axis=-1)
    a_out = multiscale_pool(u_pool, pool_mix, pool_scale)
    b_out = latent_attention(cq, ckv, kr, q_norm, kv_norm, w_uq, w_uk, w_uv, cos, sin)
    m_out = memory_attention(qx, rmsnorm(mem, mem_norm), w_mem_kv)
    br = jnp.stack([a_out, b_out, m_out], axis=2)
    br = jnp.einsum('bsnc,ncd->bsnd', br, w_branch)
    g = jax.nn.sigmoid(h @ w_gate + b_gate).reshape(B, S, N_BRANCH, D)
    merged = jnp.sum(g * br, axis=2)
    x = x + rmsnorm(merged @ w_out, ln_mix_post)
    h = rmsnorm(x, ln_ffn_pre)
    gu = h @ w_gu
    f = (jax.nn.silu(gu[..., :D_FF]) * gu[..., D_FF:]) @ w_down
    return x + rmsnorm(f, ln_ffn_post)


def setup_inputs(seed: int = 0) -> dict:
    key = jax.random.key(seed)
    ks = jax.random.split(key, 26)

    def nrm(k, shape, scale):
        return jax.random.normal(k, shape, jnp.float32) * scale

    def gain(k, shape):
        return 1.0 + 0.02 * jax.random.normal(k, shape, jnp.float32)

    L, D = DEPTH, D_MODEL
    return {
        'x_prompt': nrm(ks[0], (BATCH, SEQ, D), 1.0),
        'x_sample': nrm(ks[1], (DEC_BATCH, DEC_SEQ, D), 1.0),
        'mem_prompt': nrm(ks[2], (BATCH, N_MEM, D), 1.0),
        'mem_sample': nrm(ks[3], (DEC_BATCH, N_MEM, D), 1.0),
        'w_in': nrm(ks[4], (L, D, IN_WIDTH), D ** -0.5),
        'q_norm': gain(ks[5], (L, Q_LORA)),
        'kv_norm': gain(ks[6], (L, KV_LORA)),
        'w_uq': nrm(ks[7], (L, Q_LORA, MLA_HEADS * (QK_NOPE + QK_ROPE)), Q_LORA ** -0.5),
        'w_uk': nrm(ks[8], (L, KV_LORA, MLA_HEADS * QK_NOPE), KV_LORA ** -0.5),
        'w_uv': nrm(ks[9], (L, KV_LORA, MLA_HEADS * V_HEAD), KV_LORA ** -0.5),
        'pool_mix': nrm(ks[10], (L, POOL_GROUPS, POOL_GROUP_W, POOL_GROUP_W), POOL_GROUP_W ** -0.5),
        'pool_scale': gain(ks[11], (L, POOL_WIDTH)),
        'mem_norm': gain(ks[12], (L, D)),
        'w_mem_kv': nrm(ks[13], (L, D, 2 * X_WIDTH), D ** -0.5),
        'w_branch': nrm(ks[14], (L, N_BRANCH, BRANCH_WIDTH, D), BRANCH_WIDTH ** -0.5),
        'w_gate': nrm(ks[15], (L, D, N_BRANCH * D), D ** -0.5),
        'b_gate': nrm(ks[16], (L, N_BRANCH * D), 0.02),
        'w_out': nrm(ks[17], (L, D, D), D ** -0.5),
        'ln_mix_pre': gain(ks[18], (L, D)),
        'ln_mix_post': gain(ks[19], (L, D)),
        'ln_ffn_pre': gain(ks[20], (L, D)),
        'ln_ffn_post': gain(ks[21], (L, D)),
        'w_gu': nrm(ks[22], (L, D, 2 * D_FF), D ** -0.5),
        'w_down': nrm(ks[23], (L, D_FF, D), D_FF ** -0.5),
    }


def reference(x_prompt, x_sample, mem_prompt, mem_sample, w_in, q_norm, kv_norm, w_uq, w_uk, w_uv,
              pool_mix, pool_scale, mem_norm, w_mem_kv, w_branch, w_gate, b_gate, w_out,
              ln_mix_pre, ln_mix_post, ln_ffn_pre, ln_ffn_post, w_gu, w_down):
    def trunk(x, mem):
        cos, sin = rope_tables(x.shape[1], x.dtype)
        for l in range(DEPTH):
            x = encoder_layer(x, mem, cos, sin, w_in[l], q_norm[l], kv_norm[l], w_uq[l], w_uk[l], w_uv[l],
                              pool_mix[l], pool_scale[l], mem_norm[l], w_mem_kv[l], w_branch[l],
                              w_gate[l], b_gate[l], w_out[l], ln_mix_pre[l], ln_mix_post[l],
                              ln_ffn_pre[l], ln_ffn_post[l], w_gu[l], w_down[l])
        return x

    y_prompt = trunk(x_prompt, mem_prompt)
    y_sample = trunk(x_sample, mem_sample)
    return (y_prompt, y_sample)
```

```cpp
#include <hip/hip_runtime.h>
#include <hip/hip_cooperative_groups.h>
#include <hip/hip_bf16.h>
#include <cstdio>
#include <cstdint>
namespace cg = cooperative_groups;

constexpr int DM = 1024, NL = 4, TG = 32768, NGRP = 3, NMG = TG / 256;
constexpr int INW = 1696, INP = 1792;
constexpr int Z_CQ = 512, Z_CKV = 896, Z_KR = 1152, Z_QX = 1184;
constexpr int QL = 384, KVL = 256, NH = 8, QKD = 96, VD = 64, QW = NH * QKD, VW = NH * VD;
constexpr int DFF = 2816, NMEMROWS = 6144;
constexpr float EPS = 1e-6f;
constexpr size_t WO_IN = 0, WO_GATE = WO_IN + (size_t)INP * 1024, WO_UQ = WO_GATE + (size_t)3072 * 1024, WO_UKV = WO_UQ + (size_t)768 * 384,
                 WO_POOL = WO_UKV + (size_t)1024 * 256, WO_BR = WO_POOL + (size_t)512 * 512, WO_OUT = WO_BR + (size_t)3072 * 512,
                 WO_GU = WO_OUT + (size_t)1024 * 1024, WO_DOWN = WO_GU + (size_t)5632 * 1024, W_LAYER = WO_DOWN + (size_t)1024 * 2816;
constexpr size_t MiB = 1u << 20;
constexpr size_t WS_ROPE = 1 * MiB;
constexpr size_t WS_MEMB = 2 * MiB;
constexpr size_t WS_KVMEM = 16 * MiB;
constexpr size_t WS_W = 68 * MiB;
constexpr size_t WS_WMEM = WS_W + 4 * W_LAYER * 2;
constexpr size_t WS_ACT = 216 * MiB;
static_assert(WS_WMEM + (size_t)4096 * 1024 * 2 <= WS_ACT, "weights fit");
constexpr size_t A_R1 = WS_ACT;
constexpr size_t A_Z = A_R1, A_DIFF = A_Z + (size_t)TG * INP * 2, A_Q = A_DIFF + (size_t)TG * 512 * 2;
constexpr size_t A_BR = A_R1, A_HID = A_R1;
constexpr size_t A_HN = A_R1 + 192 * MiB;
constexpr size_t A_K = A_HN + 64 * MiB;
constexpr size_t A_V = A_K + 48 * MiB;
constexpr size_t A_BRIN = A_V + 32 * MiB;
constexpr size_t A_MERGED = A_BRIN + 96 * MiB;
constexpr size_t A_Y = A_MERGED + 64 * MiB;
constexpr size_t A_RQ = A_Y + 64 * MiB;
constexpr size_t A_MPART = A_RQ + 1 * MiB;
constexpr size_t WS_END = A_MPART + 64 * MiB;
static_assert(A_Q + (size_t)TG * QW * 2 <= A_HN && (size_t)TG * 3072 * 2 <= 192 * MiB && (size_t)TG * DFF * 2 <= 192 * MiB, "R1 overlay");
static_assert(WS_END <= (size_t)1024 * MiB, "workspace");
constexpr int LDS_BYTES = 147456;

namespace pg8 {
#define GAS __attribute__((address_space(1)))
#define PG8_LAS __attribute__((address_space(3)))
typedef unsigned short bf16_t;
typedef short bf16x8 __attribute__((ext_vector_type(8)));
typedef float f32x4 __attribute__((ext_vector_type(4)));
typedef unsigned u32x4 __attribute__((ext_vector_type(4)));
constexpr int BM = 256, BK = 64, HALF = 128, HTB = HALF * BK * 2  , STAGE_BYTES = 8 * HTB, NXCD = 8, WGM = 8;

__host__ __device__ __forceinline__ int lds_byte(int r, int c) { const int st = (r >> 4) * 2 + (c >> 5), rr = r & 15, cc = c & 31, ob = rr * 64 + cc * 2; return st * 1024 + (ob ^ (((ob >> 9) & 1) << 5)); }
__host__ __device__ __forceinline__ void stage_rc(int b, int& R, int& C) { const int st = b / 1024, sb = b % 1024, swz = sb ^ (((sb >> 9) & 1) << 5); R = (st >> 1) * 16 + swz / 64; C = (st & 1) * 32 + (swz % 64) / 2; }
__host__ __device__ __forceinline__ int perm32(int rho) { const int n = rho >> 4, i = rho & 15; return 8 * (i >> 2) + 4 * n + (i & 3); }

struct Unit { int pm, pn; };
struct Gemm { const bf16_t* A; const bf16_t* Bt; int lda, K; };

struct StaticOrder {
    int nM, nN, nwg, G, c;
    __host__ __device__ void init(int M, int N, int G_, int c_) { nM = M / BM; nN = N / BM; nwg = nM * nN; G = G_; c = c_; }
    __host__ __device__ bool next(int i, Unit& u) const { return at((long)i * G + c, u); }
    __host__ __device__ bool at(long L, Unit& u) const {
        if (L >= nwg) return false;
        int wgid = (int)L; { const int q = nwg / NXCD, r = nwg % NXCD, xcd = wgid % NXCD, off = wgid / NXCD; wgid = (xcd < r ? xcd * (q + 1) : r * (q + 1) + (xcd - r) * q) + off; }
        const int nig = WGM * nN, gid = wgid / nig, fm = gid * WGM, gsz = (nM - fm) < WGM ? (nM - fm) : WGM;
        u.pm = fm + ((wgid % nig) % gsz); u.pn = (wgid % nig) / gsz; return true;
    }
    __device__ __forceinline__ void a_ready(const Unit&) const {}
    __device__ __forceinline__ void done(const Unit&) const {}
};

struct GateOrder {
    StaticOrder B;
    __device__ void init(int M, int G_, int c_) { B.init(M, 1024, G_, c_); }
    __device__ bool next(int i, Unit& u) const { Unit t; if (!B.next(i / 3, t)) return false; u.pm = t.pm; u.pn = (i % 3) * 4 + t.pn; return true; }
    __device__ __forceinline__ void a_ready(const Unit&) const {}
    __device__ __forceinline__ void done(const Unit&) const {}
};
struct BranchOrder {
    StaticOrder B; int nM;
    __device__ void init(int M, int G_, int c_) { B.init(M, 3072, G_, c_); nM = M / BM; }
    __device__ bool next(int i, Unit& u) const { if (!B.next(i, u)) return false; u.pm += (u.pn >> 2) * nM; return true; }
    __device__ __forceinline__ void a_ready(const Unit&) const {}
    __device__ __forceinline__ void done(const Unit&) const {}
};

__device__ __forceinline__ unsigned cvt_pk_bf16(float lo, float hi) { unsigned r; asm volatile("v_cvt_pk_bf16_f32 %0, %1, %2" : "=v"(r) : "v"(lo), "v"(hi)); return r; }
__device__ __forceinline__ float bf_lo(unsigned w) { return __uint_as_float(w << 16); }
__device__ __forceinline__ float bf_hi(unsigned w) { return __uint_as_float(w & 0xffff0000u); }
__device__ __forceinline__ float sigmoidf_(float x) { return __builtin_amdgcn_rcpf(1.0f + __builtin_amdgcn_exp2f(-1.4426950408889634f * x)); }
__device__ __forceinline__ u32x4 pack8(const f32x4& a, const f32x4& b) { u32x4 w; w.x = cvt_pk_bf16(a[0], a[1]); w.y = cvt_pk_bf16(a[2], a[3]); w.z = cvt_pk_bf16(b[0], b[1]); w.w = cvt_pk_bf16(b[2], b[3]); return w; }

enum { EP_STORE = 0, EP_Q = 1, EP_KV = 2, EP_BR = 3, EP_GATE = 4, EP_SWIGLU = 5, EP_G2 = 6 };
template <int MODE> struct Epi {
    static constexpr bool PERM = true, AFTER_DRAIN = false;
    bf16_t* O; int ldc;
    bf16_t* O2;
    const float* rs;
    const float* cs; const float* sn;
    int seqmask;
    int nM;
    bf16_t* O3;
    bf16_t* O4;
    const float* rs2;
    __device__ __forceinline__ void operator()(const f32x4 (&acc)[2][2][4][2], const Unit& u, int wr, int wc, int fr_, int fq_) const {
        int z_ = 0; asm volatile("" : "+v"(z_)); const int ln_ = __builtin_amdgcn_mbcnt_hi(-1, __builtin_amdgcn_mbcnt_lo(-1, z_)), fr = ln_ & 15, fq = ln_ >> 4;
        (void)fr_; (void)fq_; const int wv_ = wr * 4 + wc; (void)wv_;
        const int pm = (MODE == EP_BR) ? (u.pm % nM) : u.pm;
        const int kind = (MODE == EP_G2) ? (u.pn < 3 ? 0 : (u.pn < 7 ? 1 : 2)) : 0;
        const int pnl = (MODE == EP_G2) ? (kind == 0 ? u.pn : (kind == 1 ? u.pn - 3 : u.pn - 7)) : u.pn;
        const int row0 = pm * BM + wr * 64 + fr, colt = pnl * BM + wc * 32 + 8 * fq;
        if constexpr (MODE == EP_SWIGLU) {
            const int hc = u.pn * 128 + wc * 32 + 8 * fq;
#pragma unroll
            for (int ai = 0; ai < 2; ++ai)
#pragma unroll
                for (int m = 0; m < 4; ++m) { const int row = row0 + ai * HALF + m * 16; f32x4 h0, h1; const float rr = ((const GAS float*)rs2)[row];
#pragma unroll
                    for (int j = 0; j < 4; ++j) { const float g0 = acc[ai][0][m][0][j] * rr, g1 = acc[ai][0][m][1][j] * rr;
                        h0[j] = g0 * sigmoidf_(g0) * (acc[ai][1][m][0][j] * rr); h1[j] = g1 * sigmoidf_(g1) * (acc[ai][1][m][1][j] * rr); }
                    *(GAS u32x4*)(O + (size_t)row * ldc + hc) = pack8(h0, h1); }
        } else {
#pragma unroll
            for (int ai = 0; ai < 2; ++ai)
#pragma unroll
                for (int m = 0; m < 4; ++m) { const int row = row0 + ai * HALF + m * 16;
                    float sc = 1.f; if constexpr (MODE == EP_Q || MODE == EP_KV) sc = ((const GAS float*)rs)[row]; if constexpr (MODE == EP_GATE) { if (u.pn < 12) sc = ((const GAS float*)rs2)[row]; }
                    if constexpr (MODE == EP_G2) { if (kind == 0) sc = ((const GAS float*)rs)[row]; else if (kind == 1) sc = ((const GAS float*)rs2)[row]; }
#pragma unroll
                    for (int bj = 0; bj < 2; ++bj) { const int col = colt + bj * HALF; f32x4 v0 = acc[ai][bj][m][0] * sc, v1 = acc[ai][bj][m][1] * sc;
                        if constexpr (MODE == EP_STORE) { *(GAS u32x4*)(O + (size_t)row * ldc + col) = pack8(v0, v1); }
                        else if constexpr (MODE == EP_BR) {
                            ((GAS u32x4*)O)[((size_t)((((pm * 12 + u.pn) * 2 + ai) * 4 + m) * 2 + bj)) * 512 + wv_ * 64 + ln_] = pack8(v0, v1); }
                        else if constexpr (MODE == EP_Q) { *(GAS u32x4*)(O + (size_t)row * ldc + col) = pack8(v0, v1); }
                        else if constexpr (MODE == EP_G2) {
                            if (kind == 0) *(GAS u32x4*)(O + (size_t)row * QW + col) = pack8(v0, v1);
                            else if (kind == 1) { if (col < 512) *(GAS u32x4*)(O2 + (size_t)row * QW + (col >> 6) * QKD + (col & 63)) = pack8(v0, v1); else *(GAS u32x4*)(O3 + (size_t)row * VW + (col - 512)) = pack8(v0, v1); }
                            else *(GAS u32x4*)(O4 + (size_t)row * 512 + col) = pack8(v0, v1); }
                        else if constexpr (MODE == EP_KV) {
                            if (col < 512) *(GAS u32x4*)(O + (size_t)row * QW + (col >> 6) * QKD + (col & 63)) = pack8(v0, v1);
                            else *(GAS u32x4*)(O2 + (size_t)row * VW + (col - 512)) = pack8(v0, v1); }
                        else if constexpr (MODE == EP_GATE) {
                            GAS u32x4* brs = (GAS u32x4*)O2 + ((size_t)((ai * 4 + m) * 2 + bj)) * 512 + wv_ * 64 + ln_;
                            if (u.pn >= 12) { *brs = pack8(v0, v1); continue; }
                            const int n = u.pn >> 2, d = col - n * 1024;
                            const f32x4 b0 = *(const GAS f32x4*)(rs + col), b1 = *(const GAS f32x4*)(rs + col + 4);
                            const u32x4 br = *brs;
                            f32x4 r0, r1;
                            r0[0] = sigmoidf_(v0[0] + b0[0]) * bf_lo(br.x); r0[1] = sigmoidf_(v0[1] + b0[1]) * bf_hi(br.x); r0[2] = sigmoidf_(v0[2] + b0[2]) * bf_lo(br.y); r0[3] = sigmoidf_(v0[3] + b0[3]) * bf_hi(br.y);
                            r1[0] = sigmoidf_(v1[0] + b1[0]) * bf_lo(br.z); r1[1] = sigmoidf_(v1[1] + b1[1]) * bf_hi(br.z); r1[2] = sigmoidf_(v1[2] + b1[2]) * bf_lo(br.w); r1[3] = sigmoidf_(v1[3] + b1[3]) * bf_hi(br.w);
                            GAS u32x4* mpart = (GAS u32x4*)O3 + ((size_t)((((pm * 4 + (u.pn & 3)) * 2 + ai) * 4 + m) * 2 + bj)) * 512 + wv_ * 64 + ln_;
                            if (n > 0) { const u32x4 pv = *mpart;
                                r0[0] += bf_lo(pv.x); r0[1] += bf_hi(pv.x); r0[2] += bf_lo(pv.y); r0[3] += bf_hi(pv.y); r1[0] += bf_lo(pv.z); r1[1] += bf_hi(pv.z); r1[2] += bf_lo(pv.w); r1[3] += bf_hi(pv.w); }
                            if (n < 2) *mpart = pack8(r0, r1); else *(GAS u32x4*)(O + (size_t)row * ldc + d) = pack8(r0, r1); }
                    } }
        }
    }
};

template <class Epi, class Sched, bool ALIGN_EPI = false, bool SP2 = false>
__device__ __forceinline__ void gemm_phase(PG8_LAS unsigned char* lds, const Gemm g, const Sched& S, const Epi& E, int tid_in) {
    int tid_ = tid_in; asm volatile("" : "+v"(tid_));
    const int tid = tid_, wid = __builtin_amdgcn_readfirstlane(tid >> 6), lane = tid & 63, wr = wid >> 2, wc = wid & 3, fr = lane & 15, fq = lane >> 4;
    const int K = g.K, nt = K / BK;
    unsigned voffA[2], voffB[2];
#pragma unroll
    for (int i = 0; i < 2; ++i) { int R, C; stage_rc(tid * 16 + i * 8192, R, C); const int Rb = Epi::PERM ? ((R & ~31) + perm32(R & 31)) : R;
        voffA[i] = (unsigned)(R * g.lda + C) * 2u; voffB[i] = (unsigned)(Rb * K + C) * 2u; }
    const size_t kstep = (size_t)(BK * 2);
    const size_t hstepA = (size_t)HALF * g.lda * 2, hstepB = (size_t)HALF * K * 2;
    const size_t tstepA = 2 * hstepA, tstepB = 2 * hstepB;
    const unsigned ldsw = (unsigned)wid * 1024u;
    const int aoff = lds_byte(wr * 64 + fr, fq * 8), boff = lds_byte(wc * 32 + fr, fq * 8);
#define PG8_SA(b, h) (((b) * 2 + (h)) * HTB)
#define PG8_SB(b, h) ((4 + (b) * 2 + (h)) * HTB)
#define PG8_STAGE(bufoff, gbase, voff) do { _Pragma("unroll") for (int _i = 0; _i < 2; ++_i) \
        __builtin_amdgcn_global_load_lds((const unsigned*)((const char*)(gbase) + (voff)[_i]), (PG8_LAS unsigned*)(lds + (bufoff) + ldsw + _i * 8192), 16, 0, 0); } while (0)
#define PG8_LDA(dst, b, h) do { _Pragma("unroll") for (int m = 0; m < 4; ++m) _Pragma("unroll") for (int k = 0; k < 2; ++k) dst[m][k] = *(const PG8_LAS bf16x8*)(lds + PG8_SA(b, h) + aoff + m * 2048 + k * 1024); } while (0)
#define PG8_LDB(dst, b, h) do { _Pragma("unroll") for (int n = 0; n < 2; ++n) _Pragma("unroll") for (int k = 0; k < 2; ++k) dst[n][k] = *(const PG8_LAS bf16x8*)(lds + PG8_SB(b, h) + boff + n * 2048 + k * 1024); } while (0)
#define PG8_MMA(ai, bj, At, Bt) do { __builtin_amdgcn_s_setprio(1); _Pragma("unroll") for (int m = 0; m < 4; ++m) _Pragma("unroll") for (int n = 0; n < 2; ++n) _Pragma("unroll") for (int k = 0; k < 2; ++k) \
        acc[ai][bj][m][n] = __builtin_amdgcn_mfma_f32_16x16x32_bf16(Bt[n][k], At[m][k], acc[ai][bj][m][n], 0, 0, 0); __builtin_amdgcn_s_setprio(0); } while (0)
#define PG8_WAIT_V(n) asm volatile("s_waitcnt vmcnt(" #n ")" ::: "memory")
#define PG8_WAIT_L(n) asm volatile("s_waitcnt lgkmcnt(" #n ")" ::: "memory")
#define PG8_BAR __builtin_amdgcn_s_barrier()
#define PG8_SCHED __builtin_amdgcn_sched_barrier(0)
    Unit cur, nxt; int ui = 0;
    if (!S.next(0, cur)) return;
    f32x4 acc[2][2][4][2];
#pragma unroll
    for (int a = 0; a < 2; ++a)
#pragma unroll
        for (int b = 0; b < 2; ++b)
#pragma unroll
            for (int m = 0; m < 4; ++m)
#pragma unroll
                for (int n = 0; n < 2; ++n) acc[a][b][m][n] = (f32x4){0.f, 0.f, 0.f, 0.f};
    bf16x8 At[4][2], B0[2][2], B1[2][2];
    const char* cA = (const char*)g.A + (size_t)cur.pm * tstepA; const char* cB = (const char*)g.Bt + (size_t)cur.pn * tstepB;
    S.a_ready(cur);
    if constexpr (SP2) {
        PG8_STAGE(PG8_SB(0, 0), cB, voffB); PG8_STAGE(PG8_SB(0, 1), cB + hstepB, voffB); PG8_STAGE(PG8_SA(0, 0), cA, voffA); PG8_STAGE(PG8_SA(0, 1), cA + hstepA, voffA);
        if (wr == 1) PG8_BAR;
        PG8_WAIT_V(2); PG8_BAR;
        PG8_STAGE(PG8_SB(1, 0), cB + kstep, voffB); PG8_STAGE(PG8_SA(1, 0), cA + kstep, voffA); PG8_STAGE(PG8_SB(1, 1), cB + hstepB + kstep, voffB);
        PG8_WAIT_V(6); PG8_BAR;
    } else {
        PG8_STAGE(PG8_SB(0, 0), cB, voffB); PG8_STAGE(PG8_SA(0, 0), cA, voffA); PG8_STAGE(PG8_SB(0, 1), cB + hstepB, voffB); PG8_STAGE(PG8_SA(0, 1), cA + hstepA, voffA);
        if (wr == 1) PG8_BAR;
        PG8_WAIT_V(4); PG8_BAR;
        PG8_STAGE(PG8_SB(1, 0), cB + kstep, voffB); PG8_STAGE(PG8_SA(1, 0), cA + kstep, voffA); PG8_STAGE(PG8_SB(1, 1), cB + hstepB + kstep, voffB);
        PG8_WAIT_V(6); PG8_BAR;
    }
    for (;;) {
        const bool has_next = S.next(ui + 1, nxt);
        const char* nA = has_next ? (const char*)g.A + (size_t)nxt.pm * tstepA : cA; const char* nB = has_next ? (const char*)g.Bt + (size_t)nxt.pn * tstepB : cB;
        for (int t = 0; t < nt; t += 2) {
            const bool last = (t == nt - 2);
            const char* a1 = cA + (size_t)(t + 1) * kstep;
            const char* a2 = last ? nA : cA + (size_t)(t + 2) * kstep; const char* b2 = last ? nB : cB + (size_t)(t + 2) * kstep;
            const char* a3 = a2 + kstep; const char* b3 = b2 + kstep;
            if (last && has_next) S.a_ready(nxt);
            if constexpr (SP2) {
            PG8_LDB(B0, 0, 0); PG8_LDB(B1, 0, 1); PG8_SCHED; PG8_LDA(At, 0, 0); PG8_STAGE(PG8_SA(1, 1), a1 + hstepA, voffA);
            PG8_WAIT_V(8); PG8_WAIT_L(0); PG8_BAR; PG8_MMA(0, 0, At, B0); PG8_MMA(0, 1, At, B1); PG8_BAR; PG8_SCHED;
            PG8_LDA(At, 0, 1); PG8_STAGE(PG8_SB(0, 0), b2, voffB); PG8_STAGE(PG8_SB(0, 1), b2 + hstepB, voffB); PG8_STAGE(PG8_SA(0, 0), a2, voffA);
            PG8_WAIT_V(8); PG8_WAIT_L(0); PG8_BAR; PG8_MMA(1, 0, At, B0); PG8_MMA(1, 1, At, B1); PG8_BAR; PG8_SCHED;
            PG8_LDB(B0, 1, 0); PG8_LDB(B1, 1, 1); PG8_SCHED; PG8_LDA(At, 1, 0); PG8_STAGE(PG8_SA(0, 1), a2 + hstepA, voffA);
            PG8_WAIT_V(8); PG8_WAIT_L(0); PG8_BAR; PG8_MMA(0, 0, At, B0); PG8_MMA(0, 1, At, B1); PG8_BAR; PG8_SCHED;
            PG8_LDA(At, 1, 1); PG8_STAGE(PG8_SB(1, 0), b3, voffB); PG8_STAGE(PG8_SB(1, 1), b3 + hstepB, voffB); PG8_STAGE(PG8_SA(1, 0), a3, voffA);
            PG8_WAIT_V(8); PG8_WAIT_L(0); PG8_BAR; PG8_MMA(1, 0, At, B0); PG8_MMA(1, 1, At, B1); PG8_BAR; PG8_SCHED;
            } else {
            PG8_LDB(B0, 0, 0); PG8_SCHED; PG8_LDA(At, 0, 0); PG8_STAGE(PG8_SA(1, 1), a1 + hstepA, voffA);
            PG8_WAIT_L(8); PG8_BAR; PG8_WAIT_L(0); PG8_MMA(0, 0, At, B0); PG8_BAR; PG8_SCHED;
            PG8_LDB(B1, 0, 1); PG8_STAGE(PG8_SB(0, 0), b2, voffB);
            PG8_BAR; PG8_WAIT_L(0); PG8_MMA(0, 1, At, B1); PG8_BAR;
            PG8_LDA(At, 0, 1); PG8_STAGE(PG8_SA(0, 0), a2, voffA);
            PG8_BAR; PG8_WAIT_L(0); PG8_MMA(1, 0, At, B0); PG8_BAR; PG8_SCHED;
            PG8_STAGE(PG8_SB(0, 1), b2 + hstepB, voffB);
            PG8_WAIT_V(6); PG8_BAR; PG8_MMA(1, 1, At, B1); PG8_BAR;
            PG8_LDB(B0, 1, 0); PG8_SCHED; PG8_LDA(At, 1, 0); PG8_STAGE(PG8_SA(0, 1), a2 + hstepA, voffA);
            PG8_WAIT_L(8); PG8_BAR; PG8_WAIT_L(0); PG8_MMA(0, 0, At, B0); PG8_BAR; PG8_SCHED;
            PG8_LDB(B1, 1, 1); PG8_STAGE(PG8_SB(1, 0), b3, voffB);
            PG8_BAR; PG8_WAIT_L(0); PG8_MMA(0, 1, At, B1); PG8_BAR;
            PG8_LDA(At, 1, 1); PG8_STAGE(PG8_SA(1, 0), a3, voffA);
            PG8_BAR; PG8_WAIT_L(0); PG8_MMA(1, 0, At, B0); PG8_BAR; PG8_SCHED;
            PG8_STAGE(PG8_SB(1, 1), b3 + hstepB, voffB);
            PG8_WAIT_V(6); PG8_BAR; PG8_MMA(1, 1, At, B1); PG8_BAR;
            }
        }
        if constexpr (ALIGN_EPI) { if (wr == 0) PG8_BAR; }
        if constexpr (!Epi::AFTER_DRAIN) { E(acc, cur, wr, wc, fr, fq); S.done(cur); }
        if (!has_next) break;
#pragma unroll
        for (int a = 0; a < 2; ++a)
#pragma unroll
            for (int b = 0; b < 2; ++b)
#pragma unroll
                for (int m = 0; m < 4; ++m)
#pragma unroll
                    for (int n = 0; n < 2; ++n) acc[a][b][m][n] = (f32x4){0.f, 0.f, 0.f, 0.f};
        cur = nxt; cA = nA; cB = nB; ++ui;
        if constexpr (ALIGN_EPI) { if (wr == 1) PG8_BAR; }
    }
    PG8_WAIT_V(0);
    if constexpr (!ALIGN_EPI) { if (wr == 0) PG8_BAR; }
    PG8_BAR;
    if constexpr (Epi::AFTER_DRAIN) { E.fused(acc, cur, wr, wc, fr, fq, lds, wid, lane); S.done(cur); }
#undef PG8_SA
#undef PG8_SB
#undef PG8_STAGE
#undef PG8_LDA
#undef PG8_LDB
#undef PG8_MMA
#undef PG8_WAIT_V
#undef PG8_WAIT_L
#undef PG8_BAR
#undef PG8_SCHED
}

struct Desc { const char* A; const char* B; int lda, K; };
template <class Epi, class Sched>
__device__ __forceinline__ void gemm_phase_vk(PG8_LAS unsigned char* lds, const Sched& S, const Epi& E, int tid_in) {
    int tid_ = tid_in; asm volatile("" : "+v"(tid_));
    const int tid = tid_, wid = __builtin_amdgcn_readfirstlane(tid >> 6), lane = tid & 63, wr = wid >> 2, wc = wid & 3, fr = lane & 15, fq = lane >> 4;
    int RA[2], RB[2]; unsigned C2[2];
#pragma unroll
    for (int i = 0; i < 2; ++i) { int R, C; stage_rc(tid * 16 + i * 8192, R, C); RA[i] = R; RB[i] = Epi::PERM ? ((R & ~31) + perm32(R & 31)) : R; C2[i] = (unsigned)C * 2u; }
    const size_t kstep = (size_t)(BK * 2);
    const unsigned ldsw = (unsigned)wid * 1024u;
    const int aoff = lds_byte(wr * 64 + fr, fq * 8), boff = lds_byte(wc * 32 + fr, fq * 8);
#define PG8_SA(b, h) (((b) * 2 + (h)) * HTB)
#define PG8_SB(b, h) ((4 + (b) * 2 + (h)) * HTB)
#define PG8_STAGE(bufoff, gbase, voff) do { _Pragma("unroll") for (int _i = 0; _i < 2; ++_i) \
        __builtin_amdgcn_global_load_lds((const unsigned*)((const char*)(gbase) + (voff)[_i]), (PG8_LAS unsigned*)(lds + (bufoff) + ldsw + _i * 8192), 16, 0, 0); } while (0)
#define PG8_LDA(dst, b, h) do { _Pragma("unroll") for (int m = 0; m < 4; ++m) _Pragma("unroll") for (int k = 0; k < 2; ++k) dst[m][k] = *(const PG8_LAS bf16x8*)(lds + PG8_SA(b, h) + aoff + m * 2048 + k * 1024); } while (0)
#define PG8_LDB(dst, b, h) do { _Pragma("unroll") for (int n = 0; n < 2; ++n) _Pragma("unroll") for (int k = 0; k < 2; ++k) dst[n][k] = *(const PG8_LAS bf16x8*)(lds + PG8_SB(b, h) + boff + n * 2048 + k * 1024); } while (0)
#define PG8_MMA(ai, bj, At, Bt) do { __builtin_amdgcn_s_setprio(1); _Pragma("unroll") for (int m = 0; m < 4; ++m) _Pragma("unroll") for (int n = 0; n < 2; ++n) _Pragma("unroll") for (int k = 0; k < 2; ++k) \
        acc[ai][bj][m][n] = __builtin_amdgcn_mfma_f32_16x16x32_bf16(Bt[n][k], At[m][k], acc[ai][bj][m][n], 0, 0, 0); __builtin_amdgcn_s_setprio(0); } while (0)
#define PG8_WAIT_V(n) asm volatile("s_waitcnt vmcnt(" #n ")" ::: "memory")
#define PG8_WAIT_L(n) asm volatile("s_waitcnt lgkmcnt(" #n ")" ::: "memory")
#define PG8_BAR __builtin_amdgcn_s_barrier()
#define PG8_SCHED __builtin_amdgcn_sched_barrier(0)
#define VK_SETV(vA, vB, d) do { _Pragma("unroll") for (int _i = 0; _i < 2; ++_i) { vA[_i] = (unsigned)(RA[_i] * (d).lda) * 2u + C2[_i]; vB[_i] = (unsigned)(RB[_i] * (d).K) * 2u + C2[_i]; } } while (0)
    Unit cur, nxt; int ui = 0;
    if (!S.next(0, cur)) return;
    Desc dc = S.desc(cur), dn = dc;
    f32x4 acc[2][2][4][2];
#pragma unroll
    for (int a = 0; a < 2; ++a)
#pragma unroll
        for (int b = 0; b < 2; ++b)
#pragma unroll
            for (int m = 0; m < 4; ++m)
#pragma unroll
                for (int n = 0; n < 2; ++n) acc[a][b][m][n] = (f32x4){0.f, 0.f, 0.f, 0.f};
    bf16x8 At[4][2], B0[2][2], B1[2][2];
    unsigned vAc[2], vBc[2], vAn[2], vBn[2];
    VK_SETV(vAc, vBc, dc);
    size_t hAc = (size_t)HALF * dc.lda * 2, hBc = (size_t)HALF * dc.K * 2, hAn = hAc, hBn = hBc;
    const char* cA = dc.A; const char* cB = dc.B; int ntc = dc.K / BK;
    PG8_STAGE(PG8_SB(0, 0), cB, vBc); PG8_STAGE(PG8_SB(0, 1), cB + hBc, vBc); PG8_STAGE(PG8_SA(0, 0), cA, vAc); PG8_STAGE(PG8_SA(0, 1), cA + hAc, vAc);
    if (wr == 1) PG8_BAR;
    PG8_WAIT_V(2); PG8_BAR;
    PG8_STAGE(PG8_SB(1, 0), cB + kstep, vBc); PG8_STAGE(PG8_SA(1, 0), cA + kstep, vAc); PG8_STAGE(PG8_SB(1, 1), cB + hBc + kstep, vBc);
    PG8_WAIT_V(6); PG8_BAR;
    for (;;) {
        const bool has_next = S.next(ui + 1, nxt);
        if (has_next) dn = S.desc(nxt); else dn = dc;
        VK_SETV(vAn, vBn, dn); hAn = (size_t)HALF * dn.lda * 2; hBn = (size_t)HALF * dn.K * 2;
        const char* nA = dn.A; const char* nB = dn.B;
        for (int t = 0; t < ntc; t += 2) {
            const bool last = (t == ntc - 2);
            const char* a1 = cA + (size_t)(t + 1) * kstep;
            const char* a2 = last ? nA : cA + (size_t)(t + 2) * kstep; const char* b2 = last ? nB : cB + (size_t)(t + 2) * kstep;
            const char* a3 = a2 + kstep; const char* b3 = b2 + kstep;
            unsigned vA2[2], vB2[2]; vA2[0] = last ? vAn[0] : vAc[0]; vA2[1] = last ? vAn[1] : vAc[1]; vB2[0] = last ? vBn[0] : vBc[0]; vB2[1] = last ? vBn[1] : vBc[1];
            const size_t hA2 = last ? hAn : hAc, hB2 = last ? hBn : hBc;
            PG8_LDB(B0, 0, 0); PG8_LDB(B1, 0, 1); PG8_SCHED; PG8_LDA(At, 0, 0); PG8_STAGE(PG8_SA(1, 1), a1 + hAc, vAc);
            PG8_WAIT_V(8); PG8_WAIT_L(0); PG8_BAR; PG8_MMA(0, 0, At, B0); PG8_MMA(0, 1, At, B1); PG8_BAR; PG8_SCHED;
            PG8_LDA(At, 0, 1); PG8_STAGE(PG8_SB(0, 0), b2, vB2); PG8_STAGE(PG8_SB(0, 1), b2 + hB2, vB2); PG8_STAGE(PG8_SA(0, 0), a2, vA2);
            PG8_WAIT_V(8); PG8_WAIT_L(0); PG8_BAR; PG8_MMA(1, 0, At, B0); PG8_MMA(1, 1, At, B1); PG8_BAR; PG8_SCHED;
            PG8_LDB(B0, 1, 0); PG8_LDB(B1, 1, 1); PG8_SCHED; PG8_LDA(At, 1, 0); PG8_STAGE(PG8_SA(0, 1), a2 + hA2, vA2);
            PG8_WAIT_V(8); PG8_WAIT_L(0); PG8_BAR; PG8_MMA(0, 0, At, B0); PG8_MMA(0, 1, At, B1); PG8_BAR; PG8_SCHED;
            PG8_LDA(At, 1, 1); PG8_STAGE(PG8_SB(1, 0), b3, vB2); PG8_STAGE(PG8_SB(1, 1), b3 + hB2, vB2); PG8_STAGE(PG8_SA(1, 0), a3, vA2);
            PG8_WAIT_V(8); PG8_WAIT_L(0); PG8_BAR; PG8_MMA(1, 0, At, B0); PG8_MMA(1, 1, At, B1); PG8_BAR; PG8_SCHED;
        }
        if (wr == 0) PG8_BAR;
        E(acc, cur, wr, wc, fr, fq);
        if (!has_next) break;
#pragma unroll
        for (int a = 0; a < 2; ++a)
#pragma unroll
            for (int b = 0; b < 2; ++b)
#pragma unroll
                for (int m = 0; m < 4; ++m)
#pragma unroll
                    for (int n = 0; n < 2; ++n) acc[a][b][m][n] = (f32x4){0.f, 0.f, 0.f, 0.f};
        cur = nxt; dc = dn; cA = nA; cB = nB; ntc = dn.K / BK; hAc = hAn; hBc = hBn; vAc[0] = vAn[0]; vAc[1] = vAn[1]; vBc[0] = vBn[0]; vBc[1] = vBn[1]; ++ui;
        if (wr == 1) PG8_BAR;
    }
    PG8_WAIT_V(0);
    PG8_BAR;
#undef VK_SETV
#undef PG8_SA
#undef PG8_SB
#undef PG8_STAGE
#undef PG8_LDA
#undef PG8_LDB
#undef PG8_MMA
#undef PG8_WAIT_V
#undef PG8_WAIT_L
#undef PG8_BAR
#undef PG8_SCHED
}
struct GBOrder {
    StaticOrder B; const char* XBp; const char* WGp; const char* BRINp; const char* WBRp; size_t brin_n_stride;
    __device__ void init(int M, int G_, int c_) { B.init(M, 1024, G_, c_); }
    __device__ bool next(int i, Unit& u) const { Unit t; if (!B.next(i / 6, t)) return false; const int r = i % 6, n = r >> 1; u.pm = t.pm; u.pn = ((r & 1) ? 0 : 12) + n * 4 + t.pn; return true; }
    __device__ __forceinline__ Desc desc(const Unit& u) const {
        Desc d; if (u.pn < 12) { d.A = XBp + (size_t)u.pm * 256 * 1024 * 2; d.B = WGp + (size_t)u.pn * 256 * 1024 * 2; d.lda = 1024; d.K = 1024; }
        else { const int q = u.pn - 12; d.A = BRINp + (size_t)(q >> 2) * brin_n_stride + (size_t)u.pm * 256 * 512 * 2; d.B = WBRp + (size_t)q * 256 * 512 * 2; d.lda = 512; d.K = 512; }
        return d; }
};

struct G2Order {
    StaticOrder Sp, Sk, Sq; int G, c; const char* Zp; const char* DIFFp; const char* Wq; const char* Wkv; const char* Wp;
    __device__ void init(int M, int G_, int c_) { Sp.init(M, 512, G_, c_); Sk.init(M, 1024, G_, c_); Sq.init(M, 768, G_, c_); G = G_; c = c_; }
    __device__ bool next(int i, Unit& u) const { long L = (long)i * G + c;
        if (L < Sp.nwg) { Sp.at(L, u); u.pn += 7; return true; } L -= Sp.nwg;
        if (L < Sk.nwg) { Sk.at(L, u); u.pn += 3; return true; } L -= Sk.nwg;
        return Sq.at(L, u); }
    __device__ __forceinline__ Desc desc(const Unit& u) const { Desc d;
        if (u.pn < 3)      { d.A = Zp + ((size_t)u.pm * 256 * INP + Z_CQ) * 2;  d.B = Wq + (size_t)u.pn * 256 * QL * 2;        d.lda = INP; d.K = QL; }
        else if (u.pn < 7) { d.A = Zp + ((size_t)u.pm * 256 * INP + Z_CKV) * 2; d.B = Wkv + (size_t)(u.pn - 3) * 256 * KVL * 2; d.lda = INP; d.K = KVL; }
        else               { d.A = DIFFp + ((size_t)u.pm * 256 * 512 + (size_t)(u.pn - 7) * 256) * 2; d.B = Wp + (size_t)(u.pn - 7) * 256 * 256 * 2; d.lda = 512; d.K = 256; }
        return d; }
};
}
namespace att {
#define GAS __attribute__((address_space(1)))
using bf16x8 = __attribute__((ext_vector_type(8))) short;
using s16x4  = __attribute__((ext_vector_type(4))) short;
using f32x16 = __attribute__((ext_vector_type(16))) float;
using u32x4  = __attribute__((ext_vector_type(4))) unsigned;
typedef unsigned short bf16_t;
constexpr int NW = 8, QBLK = 32, KVBLK = 64;
constexpr size_t SHM_V = KVBLK * 128 * 2, SHM_K = KVBLK * 128 * 2, SHM_ATTN = 2 * SHM_V + 2 * SHM_K + NW * 64 * 4;
constexpr float THR = 8.f;
#define KSWZ(row, colB) ((row) * 256 + ((colB) ^ (((row) & 15) << 4)))
#define SBAR() __builtin_amdgcn_sched_barrier(0)
__device__ __forceinline__ int crow(int r, int hi) { return (r & 3) + 8 * (r >> 2) + 4 * hi; }
__device__ __forceinline__ unsigned cvtpk(float lo, float hi) { unsigned r; asm volatile("v_cvt_pk_bf16_f32 %0, %1, %2" : "=v"(r) : "v"(lo), "v"(hi)); return r; }

__device__ __forceinline__ void partialSM(f32x16& p0, f32x16& p1, float& m_reg, float& mn, float& alpha, const float C, const float thr_s) {
  float pmax = p0[0];
#pragma unroll
  for (int r = 1; r < 16; ++r) pmax = fmaxf(pmax, p0[r]);
#pragma unroll
  for (int r = 0; r < 16; ++r) pmax = fmaxf(pmax, p1[r]);
  { auto rr = __builtin_amdgcn_permlane32_swap(__float_as_uint(pmax), __float_as_uint(pmax), false, false);
    pmax = fmaxf(__uint_as_float(rr[0]), __uint_as_float(rr[1])); }
  if (__builtin_expect(__all(pmax - m_reg <= thr_s), 1)) { mn = m_reg; alpha = 1.f; }
  else { mn = fmaxf(m_reg, pmax); alpha = __builtin_amdgcn_exp2f((m_reg - mn) * C); m_reg = mn; }
  float mnC = -mn * C;
#pragma unroll
  for (int r = 0; r < 16; ++r) p0[r] = fmaf(p0[r], C, mnC);
#pragma unroll
  for (int r = 0; r < 16; ++r) p1[r] = fmaf(p1[r], C, mnC);
#pragma unroll
  for (int r = 0; r < 16; ++r) p0[r] = __builtin_amdgcn_exp2f(p0[r]);
}
__device__ __forceinline__ void finishSM(f32x16& p0, f32x16& p1, float alpha, float& l_reg, bf16x8& pa0, bf16x8& pa1, bf16x8& pa2, bf16x8& pa3) {
#pragma unroll
  for (int r = 0; r < 16; ++r) p1[r] = __builtin_amdgcn_exp2f(p1[r]);
  float ps = 0;
#pragma unroll
  for (int r = 0; r < 16; ++r) ps += p0[r];
#pragma unroll
  for (int r = 0; r < 16; ++r) ps += p1[r];
  { auto rr = __builtin_amdgcn_permlane32_swap(__float_as_uint(ps), __float_as_uint(ps), false, false);
    ps = __uint_as_float(rr[0]) + __uint_as_float(rr[1]); }
  l_reg = l_reg * alpha + ps;
#define PK4(P, BASE, OUT) do { u32x4 w = {cvtpk(P[BASE + 0], P[BASE + 1]), cvtpk(P[BASE + 2], P[BASE + 3]), cvtpk(P[BASE + 4], P[BASE + 5]), cvtpk(P[BASE + 6], P[BASE + 7])}; \
    OUT = *reinterpret_cast<bf16x8*>(&w); } while (0)
  PK4(p0, 0, pa0); PK4(p0, 8, pa1); PK4(p1, 0, pa2); PK4(p1, 8, pa3);
#undef PK4
}
template <int NQK> __device__ __forceinline__ void qkt(f32x16& p0, f32x16& p1, const char* Ks, const bf16x8* qr, int r32, int hi) {
  p0 = f32x16{}; p1 = f32x16{};
#pragma unroll
  for (int d0 = 0; d0 < NQK; ++d0) { int cb = (d0 * 16 + hi * 8) * 2;
    bf16x8 b0 = *reinterpret_cast<const bf16x8*>(Ks + KSWZ(r32, cb));
    bf16x8 b1 = *reinterpret_cast<const bf16x8*>(Ks + KSWZ(32 + r32, cb));
    p0 = __builtin_amdgcn_mfma_f32_32x32x16_bf16(b0, qr[d0], p0, 0, 0, 0);
    p1 = __builtin_amdgcn_mfma_f32_32x32x16_bf16(b1, qr[d0], p1, 0, 0, 0); }
}
__device__ __forceinline__ int v_st(int k, int c) { const int kk = (k & ~0xC) | ((k & 4) << 1) | ((k & 8) >> 1); return ((kk >> 3) * 4 + (c >> 5)) * 512 + ((kk & 7) * 32 + (c & 31)) * 2; }
__device__ __forceinline__ int v_st_acc(int k, int c) { return ((k >> 3) * 4 + (c >> 5)) * 512 + ((k & 7) * 32 + (c & 31)) * 2; }
__device__ __forceinline__ int v_rd_base(int lane) { return ((lane & 3) << 3) | (((lane >> 2) & 3) << 6) | (((lane >> 4) & 1) << 5) | (((lane >> 5) & 1) << 8); }
constexpr int v_rd_off(int d0, int ks, int half) { return d0 * 512 + ks * 4096 + half * 2048; }
template <int OFF> __device__ __forceinline__ s16x4 tr_read(int vb) {
  s16x4 r; asm volatile("ds_read_b64_tr_b16 %0, %1 offset:%2" : "=&v"(r) : "v"(vb), "i"(OFF) : "memory"); return r;
}
template <int D0> __device__ __forceinline__ void pv_one(f32x16& od, int vb, bf16x8 pa0, bf16x8 pa1, bf16x8 pa2, bf16x8 pa3) {
  const s16x4 l0 = tr_read<v_rd_off(D0, 0, 0)>(vb), h0 = tr_read<v_rd_off(D0, 0, 1)>(vb), l1 = tr_read<v_rd_off(D0, 1, 0)>(vb), h1 = tr_read<v_rd_off(D0, 1, 1)>(vb);
  const s16x4 l2 = tr_read<v_rd_off(D0, 2, 0)>(vb), h2 = tr_read<v_rd_off(D0, 2, 1)>(vb), l3 = tr_read<v_rd_off(D0, 3, 0)>(vb), h3 = tr_read<v_rd_off(D0, 3, 1)>(vb);
  asm volatile("s_waitcnt lgkmcnt(0)" ::: "memory"); SBAR();
#define PK(L, H) (bf16x8){L[0], L[1], L[2], L[3], H[0], H[1], H[2], H[3]}
  od = __builtin_amdgcn_mfma_f32_32x32x16_bf16(pa0, PK(l0, h0), od, 0, 0, 0);
  od = __builtin_amdgcn_mfma_f32_32x32x16_bf16(pa1, PK(l1, h1), od, 0, 0, 0);
  od = __builtin_amdgcn_mfma_f32_32x32x16_bf16(pa2, PK(l2, h2), od, 0, 0, 0);
  od = __builtin_amdgcn_mfma_f32_32x32x16_bf16(pa3, PK(l3, h3), od, 0, 0, 0);
#undef PK
}
template <int NDV> __device__ __forceinline__ void pv_d0(f32x16* o, int vb, bf16x8 pa0, bf16x8 pa1, bf16x8 pa2, bf16x8 pa3) {
  pv_one<0>(o[0], vb, pa0, pa1, pa2, pa3); pv_one<1>(o[1], vb, pa0, pa1, pa2, pa3);
  if constexpr (NDV == 4) { pv_one<2>(o[2], vb, pa0, pa1, pa2, pa3); pv_one<3>(o[3], vb, pa0, pa1, pa2, pa3); }
}

template <int NQK, int NDV, int ldq, int ldk, int ldv, int ldo, bool ROPE>
__device__ __forceinline__ void attn_dense_body(const bf16_t* Qb_, const bf16_t* Kh_, const bf16_t* Vh_,
                                                bf16_t* Ob_, int seq, const float scale, char* lds, const float* cs_, const float* sn_, int pos0, int tid_in) {
  const GAS bf16_t* Qb = (const GAS bf16_t*)Qb_; const GAS bf16_t* Kh = (const GAS bf16_t*)Kh_; const GAS bf16_t* Vh = (const GAS bf16_t*)Vh_; GAS bf16_t* Ob = (GAS bf16_t*)Ob_;
  const GAS float* cs = (const GAS float*)cs_; const GAS float* sn = (const GAS float*)sn_;
  int tid_ = tid_in; asm volatile("" : "+v"(tid_));
  const int tid = tid_, wid = tid >> 6, lane = tid & 63, r32 = lane & 31, hi = lane >> 5;
  char* V_lds = lds; char* K_lds = lds + 2 * SHM_V;
  float* ws = (float*)(lds + 2 * SHM_V + 2 * SHM_K) + wid * 64; float* li_l = ws; float* al_l = ws + 32;
  const float C = scale * 1.4426950408889634f, thr_s = THR / scale;
  float m_reg = -1e30f, l_reg = 0; f32x16 o[NDV]; bf16x8 qr[NQK];
#pragma unroll
  for (int d = 0; d < NDV; ++d) o[d] = f32x16{};
  const GAS bf16_t* Qw = Qb + (long)(wid * QBLK + r32) * ldq + hi * 8;
#pragma unroll
  for (int d0 = 0; d0 < NQK; ++d0) qr[d0] = *(const GAS bf16x8*)(Qw + d0 * 16);
  if constexpr (ROPE) {
    const int pos = pos0 + wid * QBLK + r32;
#pragma unroll
    for (int d0 = 4; d0 < 6; ++d0) { const int i0 = (d0 - 4) * 8 + hi * 4;
      typedef float f4v __attribute__((ext_vector_type(4))); const f4v c4 = *(const GAS f4v*)(cs + pos * 16 + i0), s4 = *(const GAS f4v*)(sn + pos * 16 + i0);
      u32x4 w = *reinterpret_cast<u32x4*>(&qr[d0]);
      { const float x1 = __uint_as_float(w.x << 16), x2 = __uint_as_float(w.x & 0xffff0000u); w.x = cvtpk(x1 * c4.x - x2 * s4.x, x2 * c4.x + x1 * s4.x); }
      { const float x1 = __uint_as_float(w.y << 16), x2 = __uint_as_float(w.y & 0xffff0000u); w.y = cvtpk(x1 * c4.y - x2 * s4.y, x2 * c4.y + x1 * s4.y); }
      { const float x1 = __uint_as_float(w.z << 16), x2 = __uint_as_float(w.z & 0xffff0000u); w.z = cvtpk(x1 * c4.z - x2 * s4.z, x2 * c4.z + x1 * s4.z); }
      { const float x1 = __uint_as_float(w.w << 16), x2 = __uint_as_float(w.w & 0xffff0000u); w.w = cvtpk(x1 * c4.w - x2 * s4.w, x2 * c4.w + x1 * s4.w); }
      qr[d0] = *reinterpret_cast<bf16x8*>(&w); }
  }
  constexpr bool MLA = (NQK == 6);
  static_assert((NQK == 8 && NDV == 4) || (NQK == 6 && NDV == 2), "staging plans exist for these two shapes");
  constexpr int NLD = MLA ? 3 : 4;
  const int sr = tid >> 4, sc = (tid & 15) * 8;
  const int c1 = 512 + (tid & 255);
  const int g0 = MLA ? (tid / 12) * ldk + (tid % 12) * 8 : sr * ldk + sc;
  const int g1 = MLA ? (c1 / 12) * ldk + (c1 % 12) * 8 : (32 + sr) * ldk + sc;
  const int g2 = MLA ? (tid >> 3) * ldv + (tid & 7) * 8 : sr * ldv + sc;
  const int g3 = (32 + sr) * ldv + sc;
  const int l0 = MLA ? KSWZ(tid / 12, (tid % 12) * 16) : KSWZ(sr, sc * 2);
  const int l1 = MLA ? KSWZ(c1 / 12, (c1 % 12) * 16) : KSWZ(32 + sr, sc * 2);
  const int l2 = MLA ? v_st_acc(tid >> 3, (tid & 7) * 8) : v_st_acc(sr, sc);
  const int l3 = v_st_acc(32 + sr, sc);
  const int vb0 = (int)(uintptr_t)V_lds + v_rd_base(lane);
  bf16x8 s_a[2], s_b[2], s_c[2], s_d[2];
#define SLOAD(i, k0) do { const GAS bf16_t* kp_ = Kh + (long)(k0) * ldk; const GAS bf16_t* vp_ = Vh + (long)(k0) * ldv; \
    s_a[i] = *(const GAS bf16x8*)(kp_ + g0); s_b[i] = *(const GAS bf16x8*)(kp_ + g1); s_c[i] = *(const GAS bf16x8*)(vp_ + g2); if constexpr (!MLA) s_d[i] = *(const GAS bf16x8*)(vp_ + g3); } while (0)
#define SWRITE(b, i) do { *(bf16x8*)(K_lds + (b) * SHM_K + l0) = s_a[i]; *(bf16x8*)(K_lds + (b) * SHM_K + l1) = s_b[i]; \
    *(bf16x8*)(V_lds + (b) * SHM_V + l2) = s_c[i]; if constexpr (!MLA) *(bf16x8*)(V_lds + (b) * SHM_V + l3) = s_d[i]; } while (0)
#define SWAIT() do { if constexpr (MLA) asm volatile("s_waitcnt vmcnt(3)" ::: "memory"); else asm volatile("s_waitcnt vmcnt(4)" ::: "memory"); } while (0)
#define RESC(a) do { if (__any((a) < 1.f)) { if (hi == 0) al_l[r32] = (a); asm volatile("s_waitcnt lgkmcnt(0)" ::: "memory"); \
    _Pragma("unroll") for (int d = 0; d < NDV; ++d) _Pragma("unroll") for (int r = 0; r < 16; ++r) o[d][r] *= al_l[crow(r, hi)]; } } while (0)
  f32x16 pA0, pA1, pB0, pB1; float mnA, mnB, alA, alB; bf16x8 pa0, pa1, pa2, pa3; const int NT = seq / KVBLK;
  constexpr int SE = 0, SO = 1;
  SLOAD(SE, 0); asm volatile("s_waitcnt vmcnt(0)" ::: "memory"); SWRITE(0, SE); __syncthreads();
  qkt<NQK>(pA0, pA1, K_lds, qr, r32, hi); partialSM(pA0, pA1, m_reg, mnA, alA, C, thr_s);
  SLOAD(SO, KVBLK); SLOAD(SE, (2 < NT ? 2 : NT - 1) * KVBLK);
  SWAIT(); SWRITE(1, SO); __syncthreads();
  for (int j = 1; j + 1 < NT; j += 2) {
    SBAR(); qkt<NQK>(pB0, pB1, K_lds + SHM_K, qr, r32, hi);
    finishSM(pA0, pA1, alA, l_reg, pa0, pa1, pa2, pa3); SBAR();
    SLOAD(SO, (j + 2) * KVBLK); SBAR();
    pv_d0<NDV>(o, vb0, pa0, pa1, pa2, pa3); partialSM(pB0, pB1, m_reg, mnB, alB, C, thr_s);
    __syncthreads(); SWAIT(); SWRITE(0, SE);
    RESC(alB); __syncthreads();
    SBAR(); qkt<NQK>(pA0, pA1, K_lds, qr, r32, hi);
    finishSM(pB0, pB1, alB, l_reg, pa0, pa1, pa2, pa3); SBAR();
    SLOAD(SE, (j + 3 < NT ? j + 3 : NT - 1) * KVBLK); SBAR();
    pv_d0<NDV>(o, vb0 + (int)SHM_V, pa0, pa1, pa2, pa3); partialSM(pA0, pA1, m_reg, mnA, alA, C, thr_s);
    __syncthreads(); SWAIT(); SWRITE(1, SO);
    RESC(alA); __syncthreads();
  }
  SBAR(); qkt<NQK>(pB0, pB1, K_lds + SHM_K, qr, r32, hi);
  finishSM(pA0, pA1, alA, l_reg, pa0, pa1, pa2, pa3); SBAR();
  pv_d0<NDV>(o, vb0, pa0, pa1, pa2, pa3); partialSM(pB0, pB1, m_reg, mnB, alB, C, thr_s);
  __syncthreads(); RESC(alB);
  finishSM(pB0, pB1, alB, l_reg, pa0, pa1, pa2, pa3); SBAR();
  pv_d0<NDV>(o, vb0 + (int)SHM_V, pa0, pa1, pa2, pa3);
  if (hi == 0) li_l[r32] = l_reg; asm volatile("s_waitcnt lgkmcnt(0)" ::: "memory");
  float rli[16];
#pragma unroll
  for (int r = 0; r < 16; ++r) rli[r] = __builtin_amdgcn_rcpf(li_l[crow(r, hi)]);
  GAS bf16_t* Ow = Ob + (long)(wid * QBLK) * ldo;
#pragma unroll
  for (int r = 0; r < 16; ++r) { int orow = crow(r, hi);
#pragma unroll
    for (int d0 = 0; d0 < NDV; ++d0) { const unsigned w = cvtpk(o[d0][r] * rli[r], 0.f); Ow[(long)orow * ldo + d0 * 32 + r32] = (bf16_t)(w & 0xffffu); } }
  __syncthreads();
#undef SLOAD
#undef SWRITE
#undef SWAIT
#undef RESC
}

template <int ldq, int ldk, int ldv, int ldo>
__device__ __forceinline__ void attn_mla_body(const bf16_t* Qb_, const bf16_t* Kh_, const bf16_t* Vh_, bf16_t* Ob_, int seq, char* lds, const float* cs_, const float* sn_, int pos0, int tid_in) {
  const GAS bf16_t* Qb = (const GAS bf16_t*)Qb_; const GAS bf16_t* Kh = (const GAS bf16_t*)Kh_; const GAS bf16_t* Vh = (const GAS bf16_t*)Vh_; GAS bf16_t* Ob = (GAS bf16_t*)Ob_;
  const GAS float* cs = (const GAS float*)cs_; const GAS float* sn = (const GAS float*)sn_;
  int tid_ = tid_in; asm volatile("" : "+v"(tid_));
  const int tid = tid_, wid = tid >> 6, lane = tid & 63, r32 = lane & 31, hi = lane >> 5;
  char* V_lds = lds; char* K_lds = lds + 2 * SHM_V;
  float* ws = (float*)(lds + 2 * SHM_V + 2 * SHM_K) + wid * 64; float* li_l = ws; float* al_l = ws + 32;
  constexpr float THR2 = 11.5416f;
  float mhat = 0.f, l_reg = 0.f; f32x16 o[2]; o[0] = f32x16{}; o[1] = f32x16{}; f32x16 negm = f32x16{}; bf16x8 qr[6];
  const GAS bf16_t* Qw = Qb + (long)(wid * QBLK + r32) * ldq + hi * 8;
#pragma unroll
  for (int d0 = 0; d0 < 6; ++d0) qr[d0] = *(const GAS bf16x8*)(Qw + d0 * 16);
  { const int pos = pos0 + wid * QBLK + r32;
#pragma unroll
    for (int d0 = 4; d0 < 6; ++d0) { const int i0 = (d0 - 4) * 8 + hi * 4;
      typedef float f4v __attribute__((ext_vector_type(4))); const f4v c4 = *(const GAS f4v*)(cs + pos * 16 + i0), s4 = *(const GAS f4v*)(sn + pos * 16 + i0);
      u32x4 w = *reinterpret_cast<u32x4*>(&qr[d0]);
      { const float x1 = __uint_as_float(w.x << 16), x2 = __uint_as_float(w.x & 0xffff0000u); w.x = cvtpk(x1 * c4.x - x2 * s4.x, x2 * c4.x + x1 * s4.x); }
      { const float x1 = __uint_as_float(w.y << 16), x2 = __uint_as_float(w.y & 0xffff0000u); w.y = cvtpk(x1 * c4.y - x2 * s4.y, x2 * c4.y + x1 * s4.y); }
      { const float x1 = __uint_as_float(w.z << 16), x2 = __uint_as_float(w.z & 0xffff0000u); w.z = cvtpk(x1 * c4.z - x2 * s4.z, x2 * c4.z + x1 * s4.z); }
      { const float x1 = __uint_as_float(w.w << 16), x2 = __uint_as_float(w.w & 0xffff0000u); w.w = cvtpk(x1 * c4.w - x2 * s4.w, x2 * c4.w + x1 * s4.w); }
      qr[d0] = *reinterpret_cast<bf16x8*>(&w); } }
  const int c1 = 512 + (tid & 255);
  const int g0 = (tid / 12) * ldk + (tid % 12) * 8, g1 = (c1 / 12) * ldk + (c1 % 12) * 8, g2 = (tid >> 3) * ldv + (tid & 7) * 8;
  const int l0 = KSWZ(tid / 12, (tid % 12) * 16), l1 = KSWZ(c1 / 12, (c1 % 12) * 16), l2 = v_st_acc(tid >> 3, (tid & 7) * 8);
  const int vb0 = (int)(uintptr_t)V_lds + v_rd_base(lane);
  const int kr0 = KSWZ(r32, hi * 16), kr1 = KSWZ(32 + r32, hi * 16);
  bf16x8 s_a[2], s_b[2], s_c[2];
#define SLOAD(i, k0) do { const GAS bf16_t* kp_ = Kh + (long)(k0) * ldk; const GAS bf16_t* vp_ = Vh + (long)(k0) * ldv; \
    s_a[i] = *(const GAS bf16x8*)(kp_ + g0); s_b[i] = *(const GAS bf16x8*)(kp_ + g1); s_c[i] = *(const GAS bf16x8*)(vp_ + g2); } while (0)
#define SWRITE(b, i) do { *(bf16x8*)(K_lds + (b) * SHM_K + l0) = s_a[i]; *(bf16x8*)(K_lds + (b) * SHM_K + l1) = s_b[i]; *(bf16x8*)(V_lds + (b) * SHM_V + l2) = s_c[i]; } while (0)
#define SWAIT() asm volatile("s_waitcnt vmcnt(3)" ::: "memory")
#define KFR(Ks, d0, half) (*reinterpret_cast<const bf16x8*>((Ks) + KSWZ((half) * 32 + r32, ((d0) * 16 + hi * 8) * 2)))
#define QKT(C0, C1, Ks) do { const bf16x8 k00 = KFR(Ks, 0, 0), k01 = KFR(Ks, 0, 1), k10 = KFR(Ks, 1, 0), k11 = KFR(Ks, 1, 1), k20 = KFR(Ks, 2, 0), k21 = KFR(Ks, 2, 1), k30 = KFR(Ks, 3, 0), k31 = KFR(Ks, 3, 1); SBAR(); \
    C0 = __builtin_amdgcn_mfma_f32_32x32x16_bf16(k00, qr[0], negm, 0, 0, 0); C1 = __builtin_amdgcn_mfma_f32_32x32x16_bf16(k01, qr[0], negm, 0, 0, 0); \
    const bf16x8 k40 = KFR(Ks, 4, 0), k41 = KFR(Ks, 4, 1), k50 = KFR(Ks, 5, 0), k51 = KFR(Ks, 5, 1); \
    C0 = __builtin_amdgcn_mfma_f32_32x32x16_bf16(k10, qr[1], C0, 0, 0, 0); C1 = __builtin_amdgcn_mfma_f32_32x32x16_bf16(k11, qr[1], C1, 0, 0, 0); \
    C0 = __builtin_amdgcn_mfma_f32_32x32x16_bf16(k20, qr[2], C0, 0, 0, 0); C1 = __builtin_amdgcn_mfma_f32_32x32x16_bf16(k21, qr[2], C1, 0, 0, 0); \
    C0 = __builtin_amdgcn_mfma_f32_32x32x16_bf16(k30, qr[3], C0, 0, 0, 0); C1 = __builtin_amdgcn_mfma_f32_32x32x16_bf16(k31, qr[3], C1, 0, 0, 0); \
    C0 = __builtin_amdgcn_mfma_f32_32x32x16_bf16(k40, qr[4], C0, 0, 0, 0); C1 = __builtin_amdgcn_mfma_f32_32x32x16_bf16(k41, qr[4], C1, 0, 0, 0); \
    C0 = __builtin_amdgcn_mfma_f32_32x32x16_bf16(k50, qr[5], C0, 0, 0, 0); C1 = __builtin_amdgcn_mfma_f32_32x32x16_bf16(k51, qr[5], C1, 0, 0, 0); } while (0)
#define ROWMAX(C0, C1, rm) do { float a_ = fmaxf(fmaxf(C0[0], C0[1]), C1[0]), b_ = fmaxf(fmaxf(C0[2], C0[3]), C1[1]); a_ = fmaxf(fmaxf(a_, C1[2]), C1[3]); \
    _Pragma("unroll") for (int r = 4; r < 16; r += 4) { a_ = fmaxf(fmaxf(a_, C0[r]), C0[r + 1]); b_ = fmaxf(fmaxf(b_, C0[r + 2]), C0[r + 3]); a_ = fmaxf(fmaxf(a_, C1[r]), C1[r + 1]); b_ = fmaxf(fmaxf(b_, C1[r + 2]), C1[r + 3]); } \
    rm = fmaxf(a_, b_); auto rr_ = __builtin_amdgcn_permlane32_swap(__float_as_uint(rm), __float_as_uint(rm), false, false); rm = fmaxf(__uint_as_float(rr_[0]), __uint_as_float(rr_[1])); } while (0)
#define DECIDE(C0, C1, alpha) do { float rm_; ROWMAX(C0, C1, rm_); alpha = 1.f; \
    if (__builtin_expect(__any(rm_ > THR2), 0)) { const float dl_ = fmaxf(rm_, 0.f); mhat += dl_; \
      _Pragma("unroll") for (int r = 0; r < 16; ++r) { C0[r] -= dl_; C1[r] -= dl_; } \
      _Pragma("unroll") for (int r = 0; r < 16; ++r) negm[r] = -mhat; \
      alpha = __builtin_amdgcn_exp2f(-dl_); l_reg *= alpha; } } while (0)
#define PINP(x) asm volatile("" : "+v"(x))
#define EXP16(P) do { _Pragma("unroll") for (int r = 0; r < 16; ++r) P[r] = __builtin_amdgcn_exp2f(P[r]); } while (0)
#define PKV(L, H) (bf16x8){L[0], L[1], L[2], L[3], H[0], H[1], H[2], H[3]}
#define PV2(vb, E0, E1) do { \
    { const s16x4 l00 = tr_read<v_rd_off(0, 0, 0)>(vb), h00 = tr_read<v_rd_off(0, 0, 1)>(vb), l10 = tr_read<v_rd_off(1, 0, 0)>(vb), h10 = tr_read<v_rd_off(1, 0, 1)>(vb); \
      const s16x4 l01 = tr_read<v_rd_off(0, 1, 0)>(vb), h01 = tr_read<v_rd_off(0, 1, 1)>(vb), l11 = tr_read<v_rd_off(1, 1, 0)>(vb), h11 = tr_read<v_rd_off(1, 1, 1)>(vb); \
      asm volatile("s_waitcnt lgkmcnt(0)" ::: "memory"); SBAR(); \
      o[0] = __builtin_amdgcn_mfma_f32_32x32x16_bf16(pa0, PKV(l00, h00), o[0], 0, 0, 0); o[1] = __builtin_amdgcn_mfma_f32_32x32x16_bf16(pa0, PKV(l10, h10), o[1], 0, 0, 0); \
      o[0] = __builtin_amdgcn_mfma_f32_32x32x16_bf16(pa1, PKV(l01, h01), o[0], 0, 0, 0); o[1] = __builtin_amdgcn_mfma_f32_32x32x16_bf16(pa1, PKV(l11, h11), o[1], 0, 0, 0); } \
    EXP16(E0); PINP(E0); \
    { const s16x4 l02 = tr_read<v_rd_off(0, 2, 0)>(vb), h02 = tr_read<v_rd_off(0, 2, 1)>(vb), l12 = tr_read<v_rd_off(1, 2, 0)>(vb), h12 = tr_read<v_rd_off(1, 2, 1)>(vb); \
      const s16x4 l03 = tr_read<v_rd_off(0, 3, 0)>(vb), h03 = tr_read<v_rd_off(0, 3, 1)>(vb), l13 = tr_read<v_rd_off(1, 3, 0)>(vb), h13 = tr_read<v_rd_off(1, 3, 1)>(vb); \
      asm volatile("s_waitcnt lgkmcnt(0)" ::: "memory"); SBAR(); \
      o[0] = __builtin_amdgcn_mfma_f32_32x32x16_bf16(pa2, PKV(l02, h02), o[0], 0, 0, 0); o[1] = __builtin_amdgcn_mfma_f32_32x32x16_bf16(pa2, PKV(l12, h12), o[1], 0, 0, 0); \
      o[0] = __builtin_amdgcn_mfma_f32_32x32x16_bf16(pa3, PKV(l03, h03), o[0], 0, 0, 0); o[1] = __builtin_amdgcn_mfma_f32_32x32x16_bf16(pa3, PKV(l13, h13), o[1], 0, 0, 0); } \
    EXP16(E1); PINP(E1); PINP(o[0]); PINP(o[1]); SBAR(); } while (0)
#define SUMPACK(P0, P1) do { float ps_ = 0.f; _Pragma("unroll") for (int r = 0; r < 16; ++r) ps_ += P0[r]; _Pragma("unroll") for (int r = 0; r < 16; ++r) ps_ += P1[r]; \
    { auto rr_ = __builtin_amdgcn_permlane32_swap(__float_as_uint(ps_), __float_as_uint(ps_), false, false); ps_ = __uint_as_float(rr_[0]) + __uint_as_float(rr_[1]); } l_reg += ps_; \
    PK4(P0, 0, pa0); PK4(P0, 8, pa1); PK4(P1, 0, pa2); PK4(P1, 8, pa3); } while (0)
#define PK4(P, BASE, OUT) do { u32x4 w = {cvtpk(P[BASE + 0], P[BASE + 1]), cvtpk(P[BASE + 2], P[BASE + 3]), cvtpk(P[BASE + 4], P[BASE + 5]), cvtpk(P[BASE + 6], P[BASE + 7])}; \
    OUT = *reinterpret_cast<bf16x8*>(&w); } while (0)
#define RESC(a) do { if (__any((a) < 1.f)) { if (hi == 0) al_l[r32] = (a); asm volatile("s_waitcnt lgkmcnt(0)" ::: "memory"); \
    _Pragma("unroll") for (int d = 0; d < 2; ++d) _Pragma("unroll") for (int r = 0; r < 16; ++r) o[d][r] *= al_l[crow(r, hi)]; } } while (0)
  f32x16 pA0, pA1, pB0, pB1; float alA, alB; bf16x8 pa0, pa1, pa2, pa3; const int NT = seq / KVBLK;
  constexpr int SE = 0, SO = 1;
  SLOAD(SE, 0); asm volatile("s_waitcnt vmcnt(0)" ::: "memory"); SWRITE(0, SE); __syncthreads();
  QKT(pA0, pA1, K_lds);
  { float rm_; ROWMAX(pA0, pA1, rm_); mhat = rm_;
#pragma unroll
    for (int r = 0; r < 16; ++r) { pA0[r] -= rm_; pA1[r] -= rm_; negm[r] = -mhat; } }
  EXP16(pA0); EXP16(pA1);
#define TCL(t) (((t) < NT ? (t) : NT - 1) * KVBLK)
  SLOAD(SO, KVBLK); SLOAD(SE, TCL(2));
  SWAIT(); SWRITE(1, SO); SLOAD(SO, TCL(3)); __syncthreads();
  for (int j = 1; j + 1 < NT; j += 2) {
    SBAR(); QKT(pB0, pB1, K_lds + SHM_K); SUMPACK(pA0, pA1); SBAR();
    DECIDE(pB0, pB1, alB); SBAR();
    PV2(vb0, pB0, pB1);
    __syncthreads(); SWAIT(); SWRITE(0, SE); SLOAD(SE, TCL(j + 3));
    RESC(alB); __syncthreads();
    SBAR(); QKT(pA0, pA1, K_lds); SUMPACK(pB0, pB1); SBAR();
    DECIDE(pA0, pA1, alA); SBAR();
    PV2(vb0 + (int)SHM_V, pA0, pA1);
    __syncthreads(); SWAIT(); SWRITE(1, SO); SLOAD(SO, TCL(j + 4));
    RESC(alA); __syncthreads();
  }
  SBAR(); QKT(pB0, pB1, K_lds + SHM_K); SUMPACK(pA0, pA1); SBAR();
  DECIDE(pB0, pB1, alB); SBAR();
  PV2(vb0, pB0, pB1);
  asm volatile("s_waitcnt vmcnt(0)" ::: "memory"); __syncthreads(); RESC(alB);
  SUMPACK(pB0, pB1); SBAR();
  pv_one<0>(o[0], vb0 + (int)SHM_V, pa0, pa1, pa2, pa3); pv_one<1>(o[1], vb0 + (int)SHM_V, pa0, pa1, pa2, pa3);
  if (hi == 0) li_l[r32] = l_reg; asm volatile("s_waitcnt lgkmcnt(0)" ::: "memory");
  float rli[16];
#pragma unroll
  for (int r = 0; r < 16; ++r) rli[r] = __builtin_amdgcn_rcpf(li_l[crow(r, hi)]);
  GAS bf16_t* Ow = Ob + (long)(wid * QBLK) * ldo;
#pragma unroll
  for (int r = 0; r < 16; ++r) { int orow = crow(r, hi);
#pragma unroll
    for (int d0 = 0; d0 < 2; ++d0) { const unsigned w = cvtpk(o[d0][r] * rli[r], 0.f); Ow[(long)orow * ldo + d0 * 32 + r32] = (bf16_t)(w & 0xffffu); } }
  __syncthreads();
  (void)kr0; (void)kr1;
#undef SLOAD
#undef SWRITE
#undef SWAIT
#undef KFR
#undef QKT
#undef ROWMAX
#undef DECIDE
#undef EXP16
#undef TCL
#undef PINP
#undef PV2
#undef PKV
#undef SUMPACK
#undef PK4
#undef RESC
}

template <int ldq, int ldk, int ldv, int ldo>
__device__ __forceinline__ void attn_mla_body2(const bf16_t* Qb_, const bf16_t* Kh_, const bf16_t* Vh_, bf16_t* Ob_, int seq, char* lds, const float* cs_, const float* sn_, int pos0, int tid_in) {
  const GAS bf16_t* Qb = (const GAS bf16_t*)Qb_; const GAS bf16_t* Kh = (const GAS bf16_t*)Kh_; const GAS bf16_t* Vh = (const GAS bf16_t*)Vh_; GAS bf16_t* Ob = (GAS bf16_t*)Ob_;
  const GAS float* cs = (const GAS float*)cs_; const GAS float* sn = (const GAS float*)sn_;
  int tid_ = tid_in; asm volatile("" : "+v"(tid_));
  const int tid = tid_, wid = __builtin_amdgcn_readfirstlane(tid >> 6), lane = tid & 63, r32 = lane & 31, hi = lane >> 5;
  const int hb = wid >> 2, ht = tid & 255, dstg = 1 + hb;
  char* V_lds = lds; char* K_lds = lds + 3 * SHM_V;
  float* ws = (float*)(lds + 3 * SHM_V + 3 * SHM_K) + wid * 64; float* al_l = ws + 32;
  constexpr float THR2 = 11.5416f;
  float mhat = 0.f; f32x16 o[3]; o[0] = f32x16{}; o[1] = f32x16{}; o[2] = f32x16{}; f32x16 negm = f32x16{}; bf16x8 qr[6];
  bf16x8 ones; { const u32x4 w1 = {0x3f803f80u, 0x3f803f80u, 0x3f803f80u, 0x3f803f80u}; ones = *reinterpret_cast<const bf16x8*>(&w1); asm volatile("" : "+v"(ones)); }
  const GAS bf16_t* Qw = Qb + (long)((tid >> 6) * QBLK + r32) * ldq + hi * 8;
#pragma unroll
  for (int d0 = 0; d0 < 6; ++d0) qr[d0] = *(const GAS bf16x8*)(Qw + d0 * 16);
  { const int pos = pos0 + (tid >> 6) * QBLK + r32;
#pragma unroll
    for (int d0 = 4; d0 < 6; ++d0) { const int i0 = (d0 - 4) * 8 + hi * 4;
      typedef float f4v __attribute__((ext_vector_type(4))); const f4v c4 = *(const GAS f4v*)(cs + pos * 16 + i0), s4 = *(const GAS f4v*)(sn + pos * 16 + i0);
      u32x4 w = *reinterpret_cast<u32x4*>(&qr[d0]);
      { const float x1 = __uint_as_float(w.x << 16), x2 = __uint_as_float(w.x & 0xffff0000u); w.x = cvtpk(x1 * c4.x - x2 * s4.x, x2 * c4.x + x1 * s4.x); }
      { const float x1 = __uint_as_float(w.y << 16), x2 = __uint_as_float(w.y & 0xffff0000u); w.y = cvtpk(x1 * c4.y - x2 * s4.y, x2 * c4.y + x1 * s4.y); }
      { const float x1 = __uint_as_float(w.z << 16), x2 = __uint_as_float(w.z & 0xffff0000u); w.z = cvtpk(x1 * c4.z - x2 * s4.z, x2 * c4.z + x1 * s4.z); }
      { const float x1 = __uint_as_float(w.w << 16), x2 = __uint_as_float(w.w & 0xffff0000u); w.w = cvtpk(x1 * c4.w - x2 * s4.w, x2 * c4.w + x1 * s4.w); }
      qr[d0] = *reinterpret_cast<bf16x8*>(&w); } }
  const int kc0 = hb * 384 + ht, kc1 = hb * 384 + 256 + (ht & 127), vc = hb * 256 + ht;
  const int g0 = (kc0 / 12) * ldk + (kc0 % 12) * 8, g1 = (kc1 / 12) * ldk + (kc1 % 12) * 8, g2 = (vc >> 3) * ldv + (vc & 7) * 8;
  const int l0 = KSWZ(kc0 / 12, (kc0 % 12) * 16), l1 = KSWZ(kc1 / 12, (kc1 % 12) * 16), l2 = v_st_acc(vc >> 3, (vc & 7) * 8);
  const int vb0 = (int)(uintptr_t)V_lds + v_rd_base(lane);
  bf16x8 s_a[2], s_b[2], s_c[2];
  const int NT = seq / KVBLK;
#define TCL(t) (((t) < NT ? (t) : NT - 1) * KVBLK)
#define SLOAD(i, k0) do { const GAS bf16_t* kp_ = Kh + (long)(k0) * ldk; const GAS bf16_t* vp_ = Vh + (long)(k0) * ldv; \
    s_a[i] = *(const GAS bf16x8*)(kp_ + g0); s_b[i] = *(const GAS bf16x8*)(kp_ + g1); s_c[i] = *(const GAS bf16x8*)(vp_ + g2); } while (0)
#define SWRITE(bo, i) do { *(bf16x8*)(K_lds + (bo) + l0) = s_a[i]; *(bf16x8*)(K_lds + (bo) + l1) = s_b[i]; *(bf16x8*)(V_lds + (bo) + l2) = s_c[i]; } while (0)
#define SWAIT() asm volatile("s_waitcnt vmcnt(3)" ::: "memory")
#define KFR(Ks, d0, half) (*reinterpret_cast<const bf16x8*>((Ks) + KSWZ((half) * 32 + r32, ((d0) * 16 + hi * 8) * 2)))
#define QKT(C0, C1, Ks) do { const bf16x8 k00 = KFR(Ks, 0, 0), k01 = KFR(Ks, 0, 1), k10 = KFR(Ks, 1, 0), k11 = KFR(Ks, 1, 1), k20 = KFR(Ks, 2, 0), k21 = KFR(Ks, 2, 1), k30 = KFR(Ks, 3, 0), k31 = KFR(Ks, 3, 1); SBAR(); \
    C0 = __builtin_amdgcn_mfma_f32_32x32x16_bf16(k00, qr[0], negm, 0, 0, 0); C1 = __builtin_amdgcn_mfma_f32_32x32x16_bf16(k01, qr[0], negm, 0, 0, 0); \
    const bf16x8 k40 = KFR(Ks, 4, 0), k41 = KFR(Ks, 4, 1), k50 = KFR(Ks, 5, 0), k51 = KFR(Ks, 5, 1); \
    C0 = __builtin_amdgcn_mfma_f32_32x32x16_bf16(k10, qr[1], C0, 0, 0, 0); C1 = __builtin_amdgcn_mfma_f32_32x32x16_bf16(k11, qr[1], C1, 0, 0, 0); \
    C0 = __builtin_amdgcn_mfma_f32_32x32x16_bf16(k20, qr[2], C0, 0, 0, 0); C1 = __builtin_amdgcn_mfma_f32_32x32x16_bf16(k21, qr[2], C1, 0, 0, 0); \
    C0 = __builtin_amdgcn_mfma_f32_32x32x16_bf16(k30, qr[3], C0, 0, 0, 0); C1 = __builtin_amdgcn_mfma_f32_32x32x16_bf16(k31, qr[3], C1, 0, 0, 0); \
    C0 = __builtin_amdgcn_mfma_f32_32x32x16_bf16(k40, qr[4], C0, 0, 0, 0); C1 = __builtin_amdgcn_mfma_f32_32x32x16_bf16(k41, qr[4], C1, 0, 0, 0); \
    C0 = __builtin_amdgcn_mfma_f32_32x32x16_bf16(k50, qr[5], C0, 0, 0, 0); C1 = __builtin_amdgcn_mfma_f32_32x32x16_bf16(k51, qr[5], C1, 0, 0, 0); } while (0)
#define PKV(L, H) (bf16x8){L[0], L[1], L[2], L[3], H[0], H[1], H[2], H[3]}
#define PVALL(vb) do { \
    { const s16x4 l00 = tr_read<v_rd_off(0, 0, 0)>(vb), h00 = tr_read<v_rd_off(0, 0, 1)>(vb), l10 = tr_read<v_rd_off(1, 0, 0)>(vb), h10 = tr_read<v_rd_off(1, 0, 1)>(vb); \
      const s16x4 l01 = tr_read<v_rd_off(0, 1, 0)>(vb), h01 = tr_read<v_rd_off(0, 1, 1)>(vb), l11 = tr_read<v_rd_off(1, 1, 0)>(vb), h11 = tr_read<v_rd_off(1, 1, 1)>(vb); \
      asm volatile("s_waitcnt lgkmcnt(0)" ::: "memory"); SBAR(); \
      o[0] = __builtin_amdgcn_mfma_f32_32x32x16_bf16(pa0, PKV(l00, h00), o[0], 0, 0, 0); o[1] = __builtin_amdgcn_mfma_f32_32x32x16_bf16(pa0, PKV(l10, h10), o[1], 0, 0, 0); o[2] = __builtin_amdgcn_mfma_f32_32x32x16_bf16(pa0, ones, o[2], 0, 0, 0); \
      o[0] = __builtin_amdgcn_mfma_f32_32x32x16_bf16(pa1, PKV(l01, h01), o[0], 0, 0, 0); o[1] = __builtin_amdgcn_mfma_f32_32x32x16_bf16(pa1, PKV(l11, h11), o[1], 0, 0, 0); o[2] = __builtin_amdgcn_mfma_f32_32x32x16_bf16(pa1, ones, o[2], 0, 0, 0); } \
    { const s16x4 l02 = tr_read<v_rd_off(0, 2, 0)>(vb), h02 = tr_read<v_rd_off(0, 2, 1)>(vb), l12 = tr_read<v_rd_off(1, 2, 0)>(vb), h12 = tr_read<v_rd_off(1, 2, 1)>(vb); \
      const s16x4 l03 = tr_read<v_rd_off(0, 3, 0)>(vb), h03 = tr_read<v_rd_off(0, 3, 1)>(vb), l13 = tr_read<v_rd_off(1, 3, 0)>(vb), h13 = tr_read<v_rd_off(1, 3, 1)>(vb); \
      asm volatile("s_waitcnt lgkmcnt(0)" ::: "memory"); SBAR(); \
      o[0] = __builtin_amdgcn_mfma_f32_32x32x16_bf16(pa2, PKV(l02, h02), o[0], 0, 0, 0); o[1] = __builtin_amdgcn_mfma_f32_32x32x16_bf16(pa2, PKV(l12, h12), o[1], 0, 0, 0); o[2] = __builtin_amdgcn_mfma_f32_32x32x16_bf16(pa2, ones, o[2], 0, 0, 0); \
      o[0] = __builtin_amdgcn_mfma_f32_32x32x16_bf16(pa3, PKV(l03, h03), o[0], 0, 0, 0); o[1] = __builtin_amdgcn_mfma_f32_32x32x16_bf16(pa3, PKV(l13, h13), o[1], 0, 0, 0); o[2] = __builtin_amdgcn_mfma_f32_32x32x16_bf16(pa3, ones, o[2], 0, 0, 0); } } while (0)
#define ROWMAX(C0, C1, rm) do { float a_ = fmaxf(fmaxf(C0[0], C0[1]), C1[0]), b_ = fmaxf(fmaxf(C0[2], C0[3]), C1[1]); a_ = fmaxf(fmaxf(a_, C1[2]), C1[3]); \
    _Pragma("unroll") for (int r = 4; r < 16; r += 4) { a_ = fmaxf(fmaxf(a_, C0[r]), C0[r + 1]); b_ = fmaxf(fmaxf(b_, C0[r + 2]), C0[r + 3]); a_ = fmaxf(fmaxf(a_, C1[r]), C1[r + 1]); b_ = fmaxf(fmaxf(b_, C1[r + 2]), C1[r + 3]); } \
    rm = fmaxf(a_, b_); auto rr_ = __builtin_amdgcn_permlane32_swap(__float_as_uint(rm), __float_as_uint(rm), false, false); rm = fmaxf(__uint_as_float(rr_[0]), __uint_as_float(rr_[1])); } while (0)
#define PK4(P, BASE, OUT) do { u32x4 w = {cvtpk(P[BASE + 0], P[BASE + 1]), cvtpk(P[BASE + 2], P[BASE + 3]), cvtpk(P[BASE + 4], P[BASE + 5]), cvtpk(P[BASE + 6], P[BASE + 7])}; OUT = *reinterpret_cast<bf16x8*>(&w); } while (0)
  f32x16 C0, C1; bf16x8 pa0, pa1, pa2, pa3; s16x4 a0, a1, a2, a3;
#define VRD8(L0, H0, L1, H1, L2, H2, L3, H3, ks0, ks1, vb) do { L0 = tr_read<v_rd_off(0, ks0, 0)>(vb); H0 = tr_read<v_rd_off(0, ks0, 1)>(vb); L1 = tr_read<v_rd_off(1, ks0, 0)>(vb); H1 = tr_read<v_rd_off(1, ks0, 1)>(vb); \
    L2 = tr_read<v_rd_off(0, ks1, 0)>(vb); H2 = tr_read<v_rd_off(0, ks1, 1)>(vb); L3 = tr_read<v_rd_off(1, ks1, 0)>(vb); H3 = tr_read<v_rd_off(1, ks1, 1)>(vb); } while (0)
#define MSEG(m) do { const char* Ks_ = K_lds + bk; const int vb_ = vb0 + bvp; const bool pv_ = (m) > 0; \
    s16x4 a4, a5, a6, a7, b0, b1, b2, b3, b4, b5, b6, b7; \
    if (pv_) { a4 = tr_read<v_rd_off(0, 1, 0)>(vb_); a5 = tr_read<v_rd_off(0, 1, 1)>(vb_); a6 = tr_read<v_rd_off(1, 1, 0)>(vb_); a7 = tr_read<v_rd_off(1, 1, 1)>(vb_); } SBAR(); \
    const bf16x8 k00 = KFR(Ks_, 0, 0), k01 = KFR(Ks_, 0, 1), k10 = KFR(Ks_, 1, 0), k11 = KFR(Ks_, 1, 1); SBAR(); \
    if (pv_) { \
      o[0] = __builtin_amdgcn_mfma_f32_32x32x16_bf16(pa0, PKV(a0, a1), o[0], 0, 0, 0); o[1] = __builtin_amdgcn_mfma_f32_32x32x16_bf16(pa0, PKV(a2, a3), o[1], 0, 0, 0); o[2] = __builtin_amdgcn_mfma_f32_32x32x16_bf16(pa0, ones, o[2], 0, 0, 0); \
      asm volatile("s_waitcnt lgkmcnt(4)" ::: "memory"); SBAR(); \
      VRD8(b0, b1, b2, b3, b4, b5, b6, b7, 2, 3, vb_); \
      o[0] = __builtin_amdgcn_mfma_f32_32x32x16_bf16(pa1, PKV(a4, a5), o[0], 0, 0, 0); o[1] = __builtin_amdgcn_mfma_f32_32x32x16_bf16(pa1, PKV(a6, a7), o[1], 0, 0, 0); o[2] = __builtin_amdgcn_mfma_f32_32x32x16_bf16(pa1, ones, o[2], 0, 0, 0); } SBAR(); \
    const bf16x8 k20 = KFR(Ks_, 2, 0), k21 = KFR(Ks_, 2, 1), k30 = KFR(Ks_, 3, 0), k31 = KFR(Ks_, 3, 1); SBAR(); \
    if (pv_) { asm volatile("s_waitcnt lgkmcnt(4)" ::: "memory"); SBAR(); \
      o[0] = __builtin_amdgcn_mfma_f32_32x32x16_bf16(pa2, PKV(b0, b1), o[0], 0, 0, 0); o[1] = __builtin_amdgcn_mfma_f32_32x32x16_bf16(pa2, PKV(b2, b3), o[1], 0, 0, 0); o[2] = __builtin_amdgcn_mfma_f32_32x32x16_bf16(pa2, ones, o[2], 0, 0, 0); \
      o[0] = __builtin_amdgcn_mfma_f32_32x32x16_bf16(pa3, PKV(b4, b5), o[0], 0, 0, 0); o[1] = __builtin_amdgcn_mfma_f32_32x32x16_bf16(pa3, PKV(b6, b7), o[1], 0, 0, 0); o[2] = __builtin_amdgcn_mfma_f32_32x32x16_bf16(pa3, ones, o[2], 0, 0, 0); } SBAR(); \
    C0 = __builtin_amdgcn_mfma_f32_32x32x16_bf16(k00, qr[0], negm, 0, 0, 0); C1 = __builtin_amdgcn_mfma_f32_32x32x16_bf16(k01, qr[0], negm, 0, 0, 0); \
    const bf16x8 k40 = KFR(Ks_, 4, 0), k41 = KFR(Ks_, 4, 1), k50 = KFR(Ks_, 5, 0), k51 = KFR(Ks_, 5, 1); \
    C0 = __builtin_amdgcn_mfma_f32_32x32x16_bf16(k10, qr[1], C0, 0, 0, 0); C1 = __builtin_amdgcn_mfma_f32_32x32x16_bf16(k11, qr[1], C1, 0, 0, 0); \
    C0 = __builtin_amdgcn_mfma_f32_32x32x16_bf16(k20, qr[2], C0, 0, 0, 0); C1 = __builtin_amdgcn_mfma_f32_32x32x16_bf16(k21, qr[2], C1, 0, 0, 0); \
    C0 = __builtin_amdgcn_mfma_f32_32x32x16_bf16(k30, qr[3], C0, 0, 0, 0); C1 = __builtin_amdgcn_mfma_f32_32x32x16_bf16(k31, qr[3], C1, 0, 0, 0); \
    C0 = __builtin_amdgcn_mfma_f32_32x32x16_bf16(k40, qr[4], C0, 0, 0, 0); C1 = __builtin_amdgcn_mfma_f32_32x32x16_bf16(k41, qr[4], C1, 0, 0, 0); \
    C0 = __builtin_amdgcn_mfma_f32_32x32x16_bf16(k50, qr[5], C0, 0, 0, 0); C1 = __builtin_amdgcn_mfma_f32_32x32x16_bf16(k51, qr[5], C1, 0, 0, 0); } while (0)
#define VSEG(m, i) do { float rm_; ROWMAX(C0, C1, rm_); \
    if ((m) == 0) { mhat = rm_; _Pragma("unroll") for (int r = 0; r < 16; ++r) { C0[r] -= rm_; C1[r] -= rm_; negm[r] = -mhat; } } \
    else if (__builtin_expect(__any(rm_ > THR2), 0)) { const float dl_ = fmaxf(rm_, 0.f); mhat += dl_; \
      _Pragma("unroll") for (int r = 0; r < 16; ++r) { C0[r] -= dl_; C1[r] -= dl_; } \
      _Pragma("unroll") for (int r = 0; r < 16; ++r) negm[r] = -mhat; \
      const float al_ = __builtin_amdgcn_exp2f(-dl_); if (hi == 0) al_l[r32] = al_; asm volatile("s_waitcnt lgkmcnt(0)" ::: "memory"); \
      _Pragma("unroll") for (int d = 0; d < 3; ++d) _Pragma("unroll") for (int r = 0; r < 16; ++r) o[d][r] *= al_l[crow(r, hi)]; } \
    _Pragma("unroll") for (int r = 0; r < 16; ++r) C0[r] = __builtin_amdgcn_exp2f(C0[r]); \
    _Pragma("unroll") for (int r = 0; r < 16; ++r) C1[r] = __builtin_amdgcn_exp2f(C1[r]); \
    PK4(C0, 0, pa0); PK4(C0, 8, pa1); PK4(C1, 0, pa2); PK4(C1, 8, pa3); \
    { const int vn_ = vb0 + bk; a0 = tr_read<v_rd_off(0, 0, 0)>(vn_); a1 = tr_read<v_rd_off(0, 0, 1)>(vn_); a2 = tr_read<v_rd_off(1, 0, 0)>(vn_); a3 = tr_read<v_rd_off(1, 0, 1)>(vn_); } \
    SWAIT(); if ((m) + dstg < NT) { SWRITE(bw, i); } SLOAD(i, TCL((m) + dstg + 2)); \
    bvp = bk; bk = (bk == 2 * (int)SHM_K ? 0 : bk + (int)SHM_K); bw = (bw == 2 * (int)SHM_K ? 0 : bw + (int)SHM_K); } while (0)
  SLOAD(0, 0); SLOAD(1, TCL(1)); asm volatile("s_waitcnt vmcnt(0)" ::: "memory");
  SWRITE(0, 0); if (hb) { SWRITE((int)SHM_K, 1); }
  SLOAD(0, TCL(dstg)); SLOAD(1, TCL(dstg + 1));
  int bk = 0, bvp = 0, bw = dstg * (int)SHM_K;
  if (hb) __syncthreads();
  for (int m = 0; m < NT; m += 2) {
    __syncthreads(); __builtin_amdgcn_s_setprio(1); MSEG(m); __builtin_amdgcn_s_setprio(0);
    __syncthreads(); VSEG(m, 0);
    __syncthreads(); __builtin_amdgcn_s_setprio(1); MSEG(m + 1); __builtin_amdgcn_s_setprio(0);
    __syncthreads(); VSEG(m + 1, 1);
  }
  __syncthreads(); { PVALL(vb0 + bvp); }
  if (!hb) __syncthreads();
  asm volatile("s_waitcnt vmcnt(0)" ::: "memory");
  float rli[16];
#pragma unroll
  for (int r = 0; r < 16; ++r) rli[r] = __builtin_amdgcn_rcpf(o[2][r]);
  GAS bf16_t* Ow = Ob + (long)((tid >> 6) * QBLK) * ldo;
#pragma unroll
  for (int r = 0; r < 16; ++r) { int orow = crow(r, hi);
#pragma unroll
    for (int d0 = 0; d0 < 2; ++d0) { const unsigned w = cvtpk(o[d0][r] * rli[r], 0.f); Ow[(long)orow * ldo + d0 * 32 + r32] = (bf16_t)(w & 0xffffu); } }
  __syncthreads();
#undef TCL
#undef SLOAD
#undef SWRITE
#undef SWAIT
#undef KFR
#undef QKT
#undef PKV
#undef PVALL
#undef VRD8
#undef ROWMAX
#undef PK4
#undef MSEG
#undef VSEG
}
#undef KSWZ
#undef SBAR
}

#define LAS __attribute__((address_space(3)))
typedef unsigned short bf16_t;
typedef float f32x4 __attribute__((ext_vector_type(4)));
typedef unsigned u32x4 __attribute__((ext_vector_type(4)));
typedef unsigned u32x2 __attribute__((ext_vector_type(2)));
using pg8::cvt_pk_bf16; using pg8::bf_lo; using pg8::bf_hi;
#define LDS_WAIT() asm volatile("s_waitcnt lgkmcnt(0)" ::: "memory")

#define XB_TMO      128
#define XB_XCNT(j)  (256  + 64 * (j))
#define XB_XSUB(j)  (1280 + 64 * (j))
#define XB_XGEN(j)  (2304 + 64 * (j))
#define XB_TOP      3328
#define XB_TOPGEN   3392
#define XCD_BAR_WORDS 3456
#define XB_SPIN_CAP (1u << 18)

__device__ __forceinline__ unsigned xb_ld(unsigned* p)              { return __hip_atomic_load(p, __ATOMIC_RELAXED, __HIP_MEMORY_SCOPE_AGENT); }
__device__ __forceinline__ unsigned xb_add(unsigned* p, unsigned v) { return __hip_atomic_fetch_add(p, v, __ATOMIC_RELAXED, __HIP_MEMORY_SCOPE_AGENT); }
__device__ __forceinline__ unsigned xb_xcc_id() { return (unsigned)__builtin_amdgcn_s_getreg((3 << 11) | 20) & 0xFu; }
#define XB_SPIN(cond, bar) do { unsigned _sp = 0; while (cond) { __builtin_amdgcn_s_sleep(1); \
    if ((++_sp & 255u) == 0u) { if (xb_ld(&(bar)[XB_TMO])) break; if (_sp > XB_SPIN_CAP) { atomicAdd(&(bar)[XB_TMO], 1u); break; } } } } while (0)

struct XcdBarrier {
    unsigned* bar; unsigned x;
    volatile LAS unsigned* st;
};

__device__ __forceinline__ XcdBarrier xcd_barrier_post(unsigned* bar, volatile LAS unsigned* st) {
    XcdBarrier b; b.bar = bar; b.x = xb_xcc_id(); b.st = st;
    if (threadIdx.x == 0) (void)xb_add(&bar[XB_XCNT(b.x)], 1u);
    return b;
}
__device__ __forceinline__ void xcd_barrier_complete(unsigned* bar, unsigned x, unsigned& nloc, unsigned& nx) {
    const unsigned G = gridDim.x * gridDim.y * gridDim.z;
    unsigned sum, cnt, mine, sp = 0u;
    for (;;) {
        sum = 0u; cnt = 0u; mine = 0u;
#pragma unroll
        for (unsigned j = 0; j < 16; ++j) { const unsigned c = xb_ld(&bar[XB_XCNT(j)]); sum += c; cnt += (c > 0u) ? 1u : 0u; mine = (j == x) ? c : mine; }
        if (sum == G) break;
        __builtin_amdgcn_s_sleep(1);
        if ((++sp & 255u) == 0u) { if (xb_ld(&bar[XB_TMO])) break; if (sp > XB_SPIN_CAP) { atomicAdd(&bar[XB_TMO], 1u); break; } }
    }
    nloc = mine > 0u ? mine : 1u; nx = cnt > 0u ? cnt : 1u;
}

__device__ __forceinline__ void xcd_barrier(const XcdBarrier& b) {
    asm volatile("s_waitcnt vmcnt(0)" ::: "memory");
    __syncthreads();
    if (threadIdx.x == 0) {
        unsigned* bar = b.bar;
        __builtin_amdgcn_s_waitcnt(0);
        unsigned nloc = b.st[0], nx = b.st[1];
        if (nloc == 0u) { xcd_barrier_complete(bar, b.x, nloc, nx); b.st[0] = nloc; b.st[1] = nx; }
        const unsigned old = xb_add(&bar[XB_XSUB(b.x)], 1u);
        const unsigned gen = old / nloc;
        if (old + 1u == (gen + 1u) * nloc) {
            __builtin_amdgcn_fence(__ATOMIC_RELEASE, "agent");
            asm volatile("s_waitcnt vmcnt(0)" ::: "memory");
            const unsigned og = xb_add(&bar[XB_TOP], 1u);
            const unsigned tg = og / nx;
            if (og + 1u == (tg + 1u) * nx) xb_add(&bar[XB_TOPGEN], 1u);
            else XB_SPIN(xb_ld(&bar[XB_TOPGEN]) == tg, bar);
            __builtin_amdgcn_fence(__ATOMIC_ACQUIRE, "agent");
            xb_add(&bar[XB_XGEN(b.x)], 1u);
            asm volatile("s_waitcnt vmcnt(0)" ::: "memory");
        } else {
            XB_SPIN(xb_ld(&bar[XB_XGEN(b.x)]) == gen, bar);
            __builtin_amdgcn_fence(__ATOMIC_ACQUIRE, "agent");
            asm volatile("s_waitcnt vmcnt(0)" ::: "memory");
        }
    }
    __syncthreads();
}


struct Params { const float* in[24]; float* out; unsigned char* ws; int ph_lo, ph_hi; };
typedef const __attribute__((address_space(4))) unsigned long long* KArg;
#define PIN(i) ((const float*)ka[i])
enum { I_XP = 0, I_XS, I_MP, I_MS, I_WIN, I_QN, I_KVN, I_WUQ, I_WUK, I_WUV, I_PMIX, I_PSC, I_MEMN, I_WMEM, I_WBR, I_WGATE, I_BGATE, I_WOUT, I_LMPRE, I_LMPOST, I_LFPRE, I_LFPOST, I_WGU, I_WDOWN };

template <int M> __device__ __forceinline__ float swz_xor(float v) { return __int_as_float(__builtin_amdgcn_ds_swizzle(__float_as_int(v), (M << 10) | 0x1f)); }
__device__ __forceinline__ float wave_sum(float v) {
    v += swz_xor<1>(v); v += swz_xor<2>(v); v += swz_xor<4>(v); v += swz_xor<8>(v); v += swz_xor<16>(v);
    auto rr = __builtin_amdgcn_permlane32_swap(__float_as_uint(v), __float_as_uint(v), false, false);
    return __uint_as_float(rr[0]) + __uint_as_float(rr[1]);
}
enum { M_IN = 0, M_GATE, M_UQ, M_UKV, M_POOL, M_BR, M_OUT, M_GU, M_DOWN, M_MEM };
__device__ __forceinline__ float wval(KArg ka, int mat, int l, int k, int n) {
    switch (mat) {
    case M_IN:   return n < INW ? PIN(I_WIN)[((size_t)l * 1024 + k) * INW + n] * PIN(I_LMPRE)[l * 1024 + k] : 0.f;
    case M_GATE: return PIN(I_WGATE)[((size_t)l * 1024 + k) * 3072 + n] * PIN(I_LMPRE)[l * 1024 + k];
    case M_UQ: { const int h = n / 96, j = n % 96; const int src = j < 64 ? h * 96 + j : h * 96 + 64 + ((j - 64) >> 1) + 16 * ((j - 64) & 1);
                 return PIN(I_WUQ)[((size_t)l * QL + k) * QW + src] * PIN(I_QN)[l * QL + k] * 0.14724445f; }
    case M_UKV:  return (n < 512 ? PIN(I_WUK)[((size_t)l * KVL + k) * 512 + n] : PIN(I_WUV)[((size_t)l * KVL + k) * 512 + n - 512]) * PIN(I_KVN)[l * KVL + k];
    case M_POOL: { const int g = n >> 7, d = n & 127, gl = k >> 7, c = k & 127; return (g & 1) == gl ? PIN(I_PMIX)[(((size_t)l * 4 + g) * 128 + c) * 128 + d] * PIN(I_PSC)[l * 512 + n] : 0.f; }
    case M_BR:   { const int nb = n >> 10, d = n & 1023; return PIN(I_WBR)[(((size_t)l * 3 + nb) * 512 + k) * 1024 + d]; }
    case M_OUT:  return PIN(I_WOUT)[((size_t)l * 1024 + k) * 1024 + n];
    case M_GU:   { const int pn = n >> 8, half = (n >> 7) & 1, j = n & 127; const int src = half * DFF + pn * 128 + j; return PIN(I_WGU)[((size_t)l * 1024 + k) * 5632 + src] * PIN(I_LFPRE)[l * 1024 + k]; }
    case M_DOWN: return PIN(I_WDOWN)[((size_t)l * DFF + k) * 1024 + n];
    default:     { const int ll = n >> 10, nn = n & 1023; return PIN(I_WMEM)[((size_t)ll * 1024 + k) * 1024 + nn] * PIN(I_MEMN)[ll * 1024 + k]; }
    }
}
__device__ __forceinline__ void tr_item(KArg ka, int mat, int l, int K, bf16_t* WT, LAS float* scr, int kb, int nb, int lane) {
    const int k0 = 64 * kb, n0 = 32 * nb;
#pragma unroll 4
    for (int i = 0; i < 32; ++i) { const int kk = 2 * i + (lane >> 5); scr[kk * 33 + (lane & 31)] = wval(ka, mat, l, k0 + kk, n0 + (lane & 31)); }
    LDS_WAIT(); asm volatile("" ::: "memory");
    const int c = lane & 7;
#pragma unroll
    for (int j = 0; j < 4; ++j) { const int n = (lane >> 3) + 8 * j; const LAS float* s = scr + (8 * c) * 33 + n;
        u32x4 o; o.x = cvt_pk_bf16(s[0 * 33], s[1 * 33]); o.y = cvt_pk_bf16(s[2 * 33], s[3 * 33]); o.z = cvt_pk_bf16(s[4 * 33], s[5 * 33]); o.w = cvt_pk_bf16(s[6 * 33], s[7 * 33]);
        *(u32x4*)(WT + (size_t)(n0 + n) * K + k0 + 8 * c) = o; }
    LDS_WAIT(); asm volatile("" ::: "memory");
}
__device__ __forceinline__ void norm_rows(const float* xsrc, float* xdst, const bf16_t* Y, const float* gain, bf16_t* HN, int rows, int gw, int NGW, int lane) {
    for (int row = gw; row < rows; row += NGW) {
        const f32x4* xr = (const f32x4*)(xsrc + (size_t)row * DM) + lane;
        f32x4 v[4];
#pragma unroll
        for (int j = 0; j < 4; ++j) v[j] = xr[64 * j];
        if (Y) {
            const u32x2* yr = (const u32x2*)(Y + (size_t)row * DM) + lane; f32x4 y[4]; float ss = 0.f;
#pragma unroll
            for (int j = 0; j < 4; ++j) { const u32x2 w = yr[64 * j]; y[j] = (f32x4){bf_lo(w.x), bf_hi(w.x), bf_lo(w.y), bf_hi(w.y)}; ss += (y[j].x * y[j].x + y[j].y * y[j].y) + (y[j].z * y[j].z + y[j].w * y[j].w); }
            const float r = 1.0f / sqrtf(wave_sum(ss) * (1.f / DM) + EPS);
#pragma unroll
            for (int j = 0; j < 4; ++j) { const f32x4 g = *((const f32x4*)gain + lane + 64 * j); v[j] += y[j] * r * g; }
        }
        if (xdst) { f32x4* xo = (f32x4*)(xdst + (size_t)row * DM) + lane;
#pragma unroll
            for (int j = 0; j < 4; ++j) xo[64 * j] = v[j]; }
        if (HN) { float ss = 0.f;
#pragma unroll
            for (int j = 0; j < 4; ++j) ss += (v[j].x * v[j].x + v[j].y * v[j].y) + (v[j].z * v[j].z + v[j].w * v[j].w);
            const float r = 1.0f / sqrtf(wave_sum(ss) * (1.f / DM) + EPS);
            u32x2* o8 = (u32x2*)(HN + (size_t)row * DM) + lane;
#pragma unroll
            for (int j = 0; j < 4; ++j) { u32x2 w; w.x = cvt_pk_bf16(v[j].x * r, v[j].y * r); w.y = cvt_pk_bf16(v[j].z * r, v[j].w * r); o8[64 * j] = w; } }
    }
}

#define GASF __attribute__((address_space(1)))
__device__ __forceinline__ void resid_rows(const float* xf_, bf16_t* XB_, const bf16_t* Y_, const float* gain_, float* R_, float* outf_, int rows, int gw, int NGW, int lane) {
    u32x4 xw[2], yw[2], nxw[2], nyw[2]; f32x4 xv[4], nxv[4];
    const int last = rows - 1;
#define RR_LOAD(XW, YW, XV, r_) do { const int rr_ = (r_) < last ? (r_) : last; \
        if (xf_) { const GASF f32x4* p_ = (const GASF f32x4*)(xf_ + (size_t)rr_ * DM); XV[0] = p_[lane * 2]; XV[1] = p_[lane * 2 + 1]; XV[2] = p_[lane * 2 + 128]; XV[3] = p_[lane * 2 + 129]; } \
        else { const GASF u32x4* p_ = (const GASF u32x4*)(XB_ + (size_t)rr_ * DM); XW[0] = p_[lane]; XW[1] = p_[lane + 64]; } \
        if (Y_) { const GASF u32x4* q_ = (const GASF u32x4*)(Y_ + (size_t)rr_ * DM); YW[0] = q_[lane]; YW[1] = q_[lane + 64]; } } while (0)
    RR_LOAD(xw, yw, xv, gw);
    for (int row = gw; row < rows; row += NGW) {
        RR_LOAD(nxw, nyw, nxv, row + NGW);
        float v[16];
        if (xf_) {
#pragma unroll
            for (int j = 0; j < 2; ++j) { const f32x4 a = xv[2 * j], b = xv[2 * j + 1];
                v[8 * j + 0] = a.x; v[8 * j + 1] = a.y; v[8 * j + 2] = a.z; v[8 * j + 3] = a.w; v[8 * j + 4] = b.x; v[8 * j + 5] = b.y; v[8 * j + 6] = b.z; v[8 * j + 7] = b.w; } }
        else {
#pragma unroll
            for (int j = 0; j < 2; ++j) { const u32x4 w = xw[j];
                v[8 * j + 0] = bf_lo(w.x); v[8 * j + 1] = bf_hi(w.x); v[8 * j + 2] = bf_lo(w.y); v[8 * j + 3] = bf_hi(w.y); v[8 * j + 4] = bf_lo(w.z); v[8 * j + 5] = bf_hi(w.z); v[8 * j + 6] = bf_lo(w.w); v[8 * j + 7] = bf_hi(w.w); } }
        if (Y_) { float y[16]; float ss = 0.f;
#pragma unroll
            for (int j = 0; j < 2; ++j) { const u32x4 w = yw[j];
                y[8 * j + 0] = bf_lo(w.x); y[8 * j + 1] = bf_hi(w.x); y[8 * j + 2] = bf_lo(w.y); y[8 * j + 3] = bf_hi(w.y); y[8 * j + 4] = bf_lo(w.z); y[8 * j + 5] = bf_hi(w.z); y[8 * j + 6] = bf_lo(w.w); y[8 * j + 7] = bf_hi(w.w); }
#pragma unroll
            for (int i = 0; i < 16; ++i) ss += y[i] * y[i];
            const float r = 1.0f / sqrtf(wave_sum(ss) * (1.f / DM) + EPS);
            const GASF f32x4* gp = (const GASF f32x4*)gain_;
#pragma unroll
            for (int j = 0; j < 2; ++j) { const f32x4 a = gp[lane * 2 + 128 * j], b = gp[lane * 2 + 1 + 128 * j];
                v[8 * j + 0] += y[8 * j + 0] * r * a.x; v[8 * j + 1] += y[8 * j + 1] * r * a.y; v[8 * j + 2] += y[8 * j + 2] * r * a.z; v[8 * j + 3] += y[8 * j + 3] * r * a.w;
                v[8 * j + 4] += y[8 * j + 4] * r * b.x; v[8 * j + 5] += y[8 * j + 5] * r * b.y; v[8 * j + 6] += y[8 * j + 6] * r * b.z; v[8 * j + 7] += y[8 * j + 7] * r * b.w; } }
        if (outf_) { GASF f32x4* p = (GASF f32x4*)(outf_ + (size_t)row * DM);
#pragma unroll
            for (int j = 0; j < 2; ++j) { p[lane * 2 + 128 * j] = (f32x4){v[8 * j + 0], v[8 * j + 1], v[8 * j + 2], v[8 * j + 3]}; p[lane * 2 + 1 + 128 * j] = (f32x4){v[8 * j + 4], v[8 * j + 5], v[8 * j + 6], v[8 * j + 7]}; } }
        else { GASF u32x4* p = (GASF u32x4*)(XB_ + (size_t)row * DM); float ss = 0.f;
#pragma unroll
            for (int i = 0; i < 16; ++i) ss += v[i] * v[i];
#pragma unroll
            for (int j = 0; j < 2; ++j) { u32x4 w; w.x = cvt_pk_bf16(v[8 * j + 0], v[8 * j + 1]); w.y = cvt_pk_bf16(v[8 * j + 2], v[8 * j + 3]); w.z = cvt_pk_bf16(v[8 * j + 4], v[8 * j + 5]); w.w = cvt_pk_bf16(v[8 * j + 6], v[8 * j + 7]); p[lane + 64 * j] = w; }
            ss = wave_sum(ss);
            if (lane == 0) ((GASF float*)R_)[row] = 1.0f / sqrtf(ss * (1.f / DM) + EPS); }
        xw[0] = nxw[0]; xw[1] = nxw[1]; yw[0] = nyw[0]; yw[1] = nyw[1]; xv[0] = nxv[0]; xv[1] = nxv[1]; xv[2] = nxv[2]; xv[3] = nxv[3];
    }
#undef RR_LOAD
}
__device__ __forceinline__ void pool_rows(const bf16_t* Z_, bf16_t* DIFF_, float* RQ_, float* RKV_, bf16_t* Kb_, const float* cs_, const float* sn_, int SEQ, int gw, int NGW, int lane) {
    const GASF bf16_t* Z = (const GASF bf16_t*)Z_; GASF bf16_t* DIFF = (GASF bf16_t*)DIFF_; GASF float* RQ = (GASF float*)RQ_; GASF float* RKV = (GASF float*)RKV_; GASF bf16_t* Kb = (GASF bf16_t*)Kb_;
    const GASF float* cs = (const GASF float*)cs_; const GASF float* sn = (const GASF float*)sn_;
    const int gi = lane >> 4, half = 1 << gi, col0 = lane * 8;
#define PR_ACC(sgn, W_) do { a0 += sgn * bf_lo(W_.x); a1 += sgn * bf_hi(W_.x); a2 += sgn * bf_lo(W_.y); a3 += sgn * bf_hi(W_.y); a4 += sgn * bf_lo(W_.z); a5 += sgn * bf_hi(W_.z); a6 += sgn * bf_lo(W_.w); a7 += sgn * bf_hi(W_.w); } while (0)
    for (int blk = gw; blk < TG / 16; blk += NGW) {
        const int t0 = blk * 16, s0 = t0 & (SEQ - 1);
        const GASF bf16_t* zs = Z + (size_t)(t0 - s0) * INP + col0;
        float a0 = 0.f, a1 = 0.f, a2 = 0.f, a3 = 0.f, a4 = 0.f, a5 = 0.f, a6 = 0.f, a7 = 0.f;
#pragma unroll
        for (int dp = -8; dp < 8; ++dp) { const int p = s0 + dp; const bool ok = dp >= -half && dp < half && (unsigned)p < (unsigned)SEQ;
            const int pc = p < 0 ? 0 : (p >= SEQ ? SEQ - 1 : p); const u32x4 w = *(const GASF u32x4*)(zs + (size_t)pc * INP); const float f = ok ? 1.f : 0.f; PR_ACC(f, w); }
#pragma unroll 4
        for (int i = 0; i < 16; ++i) { const int s = s0 + i, pe = s + half, pl = s - half;
            const u32x4 wu = *(const GASF u32x4*)(zs + (size_t)s * INP);
            const u32x4 we = *(const GASF u32x4*)(zs + (size_t)(pe < SEQ ? pe : SEQ - 1) * INP);
            const u32x4 wl = *(const GASF u32x4*)(zs + (size_t)(pl >= 0 ? pl : 0) * INP);
            const int lo = pl < 0 ? 0 : pl, hi = pe > SEQ ? SEQ : pe; const float ic = 1.0f / (float)(hi - lo);
            u32x4 o; o.x = cvt_pk_bf16(a0 * ic - bf_lo(wu.x), a1 * ic - bf_hi(wu.x)); o.y = cvt_pk_bf16(a2 * ic - bf_lo(wu.y), a3 * ic - bf_hi(wu.y));
            o.z = cvt_pk_bf16(a4 * ic - bf_lo(wu.z), a5 * ic - bf_hi(wu.z)); o.w = cvt_pk_bf16(a6 * ic - bf_lo(wu.w), a7 * ic - bf_hi(wu.w));
            *(GASF u32x4*)(DIFF + (size_t)(t0 + i) * 512 + col0) = o;
            const float fe = pe < SEQ ? 1.f : 0.f, fl = pl >= 0 ? -1.f : 0.f; PR_ACC(fe, we); PR_ACC(fl, wl); }
        { const int tok = lane >> 4, sub = lane & 15;
#pragma unroll
          for (int ps = 0; ps < 4; ++ps) { const int t = t0 + ps * 4 + tok; const GASF bf16_t* zr = Z + (size_t)t * INP; float sq = 0.f, skv = 0.f;
#pragma unroll
              for (int k = 0; k < 3; ++k) { const u32x4 w = *(const GASF u32x4*)(zr + Z_CQ + sub * 24 + k * 8); float f;
                  f = bf_lo(w.x); sq += f * f; f = bf_hi(w.x); sq += f * f; f = bf_lo(w.y); sq += f * f; f = bf_hi(w.y); sq += f * f; f = bf_lo(w.z); sq += f * f; f = bf_hi(w.z); sq += f * f; f = bf_lo(w.w); sq += f * f; f = bf_hi(w.w); sq += f * f; }
#pragma unroll
              for (int k = 0; k < 2; ++k) { const u32x4 w = *(const GASF u32x4*)(zr + Z_CKV + sub * 16 + k * 8); float f;
                  f = bf_lo(w.x); skv += f * f; f = bf_hi(w.x); skv += f * f; f = bf_lo(w.y); skv += f * f; f = bf_hi(w.y); skv += f * f; f = bf_lo(w.z); skv += f * f; f = bf_hi(w.z); skv += f * f; f = bf_lo(w.w); skv += f * f; f = bf_hi(w.w); skv += f * f; }
              sq += swz_xor<1>(sq); sq += swz_xor<2>(sq); sq += swz_xor<4>(sq); sq += swz_xor<8>(sq);
              skv += swz_xor<1>(skv); skv += swz_xor<2>(skv); skv += swz_xor<4>(skv); skv += swz_xor<8>(skv);
              if (sub == 0) { RQ[t] = 1.0f / sqrtf(sq * (1.f / QL) + EPS); RKV[t] = 1.0f / sqrtf(skv * (1.f / KVL) + EPS); } }
#pragma unroll
          for (int ps = 0; ps < 4; ++ps) { const int t = t0 + ps * 4 + tok, s = t & (SEQ - 1), i = sub; const GASF bf16_t* zr = Z + (size_t)t * INP + Z_KR;
              const float x1 = __uint_as_float((unsigned)zr[i] << 16), x2 = __uint_as_float((unsigned)zr[i + 16] << 16); const float c = cs[s * 16 + i], sv = sn[s * 16 + i];
              const unsigned w = cvt_pk_bf16(x1 * c - x2 * sv, x2 * c + x1 * sv);
#pragma unroll
              for (int h = 0; h < NH; ++h) *(GASF unsigned*)(Kb + (size_t)t * QW + h * QKD + 64 + 2 * i) = w; } }
    }
#undef PR_ACC
}

__global__ void __launch_bounds__(512, 2) fwd_megakernel(Params p) {
    extern __shared__ __attribute__((aligned(16))) unsigned char lds[];
    cg::grid_group grid = cg::this_grid();
#define FRESH_TID(name) int name; { int z_ = 0; asm volatile("" : "+v"(z_)); int w_ = wave0; asm volatile("" : "+s"(w_)); name = w_ * 64 + __builtin_amdgcn_mbcnt_hi(-1, __builtin_amdgcn_mbcnt_lo(-1, z_)); }
#define PH_STATE \
    int zero_ = 0; asm volatile("" : "+v"(zero_)); const int lane = __builtin_amdgcn_mbcnt_hi(-1, __builtin_amdgcn_mbcnt_lo(-1, zero_)); \
    int wave = wave0; asm volatile("" : "+s"(wave)); const int tid = wave * 64 + lane; \
    int G = gridDim.x, bx = blockIdx.x; asm volatile("" : "+s"(G), "+s"(bx)); \
    const int vcu = (G % 8 == 0) ? (bx % 8) * (G / 8) + bx / 8 : bx; const int gw = vcu * 8 + wave, NGW = G * 8; \
    (void)lane; (void)gw; (void)NGW; (void)tid;
    LAS unsigned char* ldsl = (LAS unsigned char*)lds;
#define cs ((float*)(ws + WS_ROPE))
#define sn (cs + 8192 * 16)
#define MEMB ((bf16_t*)(ws + WS_MEMB))
#define KVMEM ((bf16_t*)(ws + WS_KVMEM))
#define WB ((bf16_t*)(ws + WS_W))
#define WMEM ((bf16_t*)(ws + WS_WMEM))
#define Z ((bf16_t*)(ws + A_Z))
#define DIFF ((bf16_t*)(ws + A_DIFF))
#define Q ((bf16_t*)(ws + A_Q))
#define BR ((bf16_t*)(ws + A_BR))
#define HID ((bf16_t*)(ws + A_HID))
#define HN ((bf16_t*)(ws + A_HN))
#define Kb ((bf16_t*)(ws + A_K))
#define Vb ((bf16_t*)(ws + A_V))
#define BRIN ((bf16_t*)(ws + A_BRIN))
#define MERGED ((bf16_t*)(ws + A_MERGED))
#define Y ((bf16_t*)(ws + A_Y))
#define RQ ((float*)(ws + A_RQ))
#define RKV (RQ + TG)
#define RX (RQ + 2 * TG)
    { volatile LAS unsigned* m_ = (volatile LAS unsigned*)((LAS unsigned char*)lds + 131072 + 320); if (threadIdx.x < 32) m_[threadIdx.x] = 0u; }
    __syncthreads();
    const XcdBarrier xbar = xcd_barrier_post((unsigned*)((unsigned char*)((KArg)__builtin_amdgcn_kernarg_segment_ptr())[25]) + 4096, (volatile LAS unsigned*)((LAS unsigned char*)lds + 131072 + 320) + 8);
    const int wave0 = __builtin_amdgcn_readfirstlane((int)threadIdx.x >> 6);
    KArg ka0 = (KArg)__builtin_amdgcn_kernarg_segment_ptr();
    const int lo = (int)(unsigned)ka0[26], hi = (int)(unsigned)(ka0[26] >> 32); int pc = 0;
#define PH_BEGIN if (pc >= lo && pc < hi) { KArg ka = ka0; asm volatile("" : "+s"(ka)); unsigned char* ws = (unsigned char*)ka[25]; PH_STATE
#define PH_END   if (pc + 1 < hi) { if (pc == 0) grid.sync(); else xcd_barrier(xbar); } } ++pc;

    PH_BEGIN
    {
        LAS float* scr = (LAS float*)(ldsl + wave * 16384);
        constexpr int IT_IN = 16 * 56, IT_GATE = 16 * 96, IT_UQ = 6 * 24, IT_UKV = 4 * 32, IT_POOL = 4 * 16, IT_BR = 8 * 96, IT_OUT = 16 * 32, IT_GU = 16 * 176, IT_DOWN = 44 * 32;
        constexpr int IT_L = IT_IN + IT_GATE + IT_UQ + IT_UKV + IT_POOL + IT_BR + IT_OUT + IT_GU + IT_DOWN, IT_MEM = 16 * 128, NIT = 4 * IT_L + IT_MEM;
        for (int it = gw; it < NIT; it += NGW) {
            if (it >= 4 * IT_L) { const int r = it - 4 * IT_L; tr_item(ka, M_MEM, 0, 1024, WMEM, scr, r / 128, r % 128, lane); continue; }
            const int l = it / IT_L; int r = it % IT_L; bf16_t* wlp = WB + (size_t)l * W_LAYER;
            if (r < IT_IN)   { tr_item(ka, M_IN, l, 1024, wlp + WO_IN, scr, r / 56, r % 56, lane); continue; } r -= IT_IN;
            if (r < IT_GATE) { tr_item(ka, M_GATE, l, 1024, wlp + WO_GATE, scr, r / 96, r % 96, lane); continue; } r -= IT_GATE;
            if (r < IT_UQ)   { tr_item(ka, M_UQ, l, QL, wlp + WO_UQ, scr, r / 24, r % 24, lane); continue; } r -= IT_UQ;
            if (r < IT_UKV)  { tr_item(ka, M_UKV, l, KVL, wlp + WO_UKV, scr, r / 32, r % 32, lane); continue; } r -= IT_UKV;
            if (r < IT_POOL) { tr_item(ka, M_POOL, l, 256, wlp + WO_POOL, scr, r / 16, r % 16, lane); continue; } r -= IT_POOL;
            if (r < IT_BR)   { tr_item(ka, M_BR, l, 512, wlp + WO_BR, scr, r / 96, r % 96, lane); continue; } r -= IT_BR;
            if (r < IT_OUT)  { tr_item(ka, M_OUT, l, 1024, wlp + WO_OUT, scr, r / 32, r % 32, lane); continue; } r -= IT_OUT;
            if (r < IT_GU)   { tr_item(ka, M_GU, l, 1024, wlp + WO_GU, scr, r / 176, r % 176, lane); continue; } r -= IT_GU;
            tr_item(ka, M_DOWN, l, DFF, wlp + WO_DOWN, scr, r / 32, r % 32, lane);
        }
        for (int e = bx * 512 + tid; e < 8192 * 16; e += G * 512) {
            const int s = e >> 4, i = e & 15;
            const float inv = 1.0f / powf(10000.0f, (float)(2 * i) / 32.0f);
            const float ang = (float)s * inv;
            const double rev = (double)ang * 0.15915494309189535; const float fr = (float)(rev - rint(rev));
            cs[e] = __builtin_amdgcn_cosf(fr); sn[e] = __builtin_amdgcn_sinf(fr);
        }
        norm_rows(PIN(I_MP), nullptr, nullptr, nullptr, MEMB, 2048, gw, NGW, lane);
        norm_rows(PIN(I_MS), nullptr, nullptr, nullptr, MEMB + (size_t)2048 * DM, 4096, gw, NGW, lane);
        asm volatile("s_waitcnt vmcnt(0) lgkmcnt(0)" ::: "memory"); __syncthreads();
    }
    PH_END
    PH_BEGIN
    {
        pg8::Gemm g{MEMB, WMEM, 1024, 1024}; pg8::StaticOrder S; S.init(NMEMROWS, 4096, G, bx);
        pg8::Epi<pg8::EP_STORE> E{}; E.O = KVMEM; E.ldc = 4096;
        pg8::gemm_phase<pg8::Epi<pg8::EP_STORE>, pg8::StaticOrder, true, true>(ldsl, g, S, E, tid);
    }
    PH_END

    for (int grp = 0; grp < NGRP; ++grp) {
        const int SEQ = grp < 2 ? 8192 : 2048;
#define xin (grp < 2 ? PIN(I_XP) + (size_t)grp * TG * DM : PIN(I_XS))
#define xout ((float*)ka[24] + (size_t)grp * TG * DM)
        const int membase = grp < 2 ? grp * 4 * 256 : 2048;
        for (int l = 0; l < NL; ++l) {
#define wl (WB + (size_t)l * W_LAYER)
            PH_BEGIN
            if (l == 0) resid_rows(xin, HN, nullptr, nullptr, RX, nullptr, TG, gw, NGW, lane);
            else        resid_rows(nullptr, HN, Y, PIN(I_LFPOST) + (l - 1) * DM, RX, nullptr, TG, gw, NGW, lane);
            PH_END
            PH_BEGIN
            { pg8::Gemm g{HN, wl + WO_IN, DM, DM}; pg8::StaticOrder S; S.init(TG, INP, G, bx);
              pg8::Epi<pg8::EP_Q> E{}; E.O = Z; E.ldc = INP; E.rs = RX;
              pg8::gemm_phase<pg8::Epi<pg8::EP_Q>, pg8::StaticOrder, true, true>(ldsl, g, S, E, tid); }
            PH_END
            PH_BEGIN
            pool_rows(Z, DIFF, RQ, RKV, Kb, cs, sn, SEQ, gw, NGW, lane);
            PH_END
            PH_BEGIN
            { pg8::G2Order S; S.init(TG, G, bx); S.Zp = (const char*)Z; S.DIFFp = (const char*)DIFF; S.Wq = (const char*)(wl + WO_UQ); S.Wkv = (const char*)(wl + WO_UKV); S.Wp = (const char*)(wl + WO_POOL);
              pg8::Epi<pg8::EP_G2> E{}; E.O = Q; E.O2 = Kb; E.O3 = Vb; E.O4 = BRIN; E.rs = RQ; E.rs2 = RKV;
              pg8::gemm_phase_vk<pg8::Epi<pg8::EP_G2>, pg8::G2Order>(ldsl, S, E, tid); }
            PH_END
            PH_BEGIN
            { const int NQB = SEQ / 256, nunits = (TG / 256) * NH;
              for (int u = vcu; u < nunits; u += G) {
                  const int bh = u / NQB, qb = u % NQB, b = bh / NH, h = bh % NH; const size_t r0 = (size_t)b * SEQ;
                  att::attn_mla_body2<QW, QW, VW, 512>(Q + (r0 + (size_t)qb * 256) * QW + h * QKD, Kb + r0 * QW + h * QKD, Vb + r0 * VW + h * VD,
                                             BRIN + (size_t)TG * 512 + (r0 + (size_t)qb * 256) * 512 + h * VD, SEQ, (char*)lds, cs, sn, qb * 256, tid);
              }
              const int nmu = (TG / 256) * 4; FRESH_TID(tidm);
              for (int u = vcu; u < nmu; u += G) {
                  const int rb = u >> 2, h = u & 3; const size_t t0 = (size_t)rb * 256; const int b = (int)(t0 / SEQ);
                  const bf16_t* kv = KVMEM + (size_t)(membase + b * 256) * 4096 + l * 1024 + h * 128;
                  att::attn_dense_body<8, 4, INP, 4096, 4096, 512, false>(Z + t0 * INP + Z_QX + h * 128, kv, kv + 512,
                                             BRIN + (size_t)2 * TG * 512 + t0 * 512 + h * 128, 256, 0.08838834764831845f, (char*)lds, cs, sn, 0, tidm);
              } }
            PH_END
            PH_BEGIN
            { pg8::GBOrder S; S.init(TG, G, bx); S.XBp = (const char*)HN; S.WGp = (const char*)(wl + WO_GATE); S.BRINp = (const char*)BRIN; S.WBRp = (const char*)(wl + WO_BR); S.brin_n_stride = (size_t)TG * 512 * 2;
              pg8::Epi<pg8::EP_GATE> E{}; E.O = MERGED; E.ldc = DM; E.O2 = BR + (size_t)bx * 65536; E.O3 = (bf16_t*)(ws + A_MPART); E.rs = PIN(I_BGATE) + l * 3072; E.rs2 = RX;
              pg8::gemm_phase_vk<pg8::Epi<pg8::EP_GATE>, pg8::GBOrder>(ldsl, S, E, tid); }
            PH_END
            PH_BEGIN
            { pg8::Gemm g{MERGED, wl + WO_OUT, DM, DM}; pg8::StaticOrder S; S.init(TG, DM, G, bx);
              pg8::Epi<pg8::EP_STORE> E{}; E.O = Y; E.ldc = DM;
              pg8::gemm_phase<pg8::Epi<pg8::EP_STORE>, pg8::StaticOrder, true, true>(ldsl, g, S, E, tid); }
            PH_END
            PH_BEGIN
            resid_rows(nullptr, HN, Y, PIN(I_LMPOST) + l * DM, RX, nullptr, TG, gw, NGW, lane);
            PH_END
            PH_BEGIN
            { pg8::Gemm g{HN, wl + WO_GU, DM, DM}; pg8::StaticOrder S; S.init(TG, 5632, G, bx);
              pg8::Epi<pg8::EP_SWIGLU> E{}; E.O = HID; E.ldc = DFF; E.rs2 = RX;
              pg8::gemm_phase<pg8::Epi<pg8::EP_SWIGLU>, pg8::StaticOrder, true, true>(ldsl, g, S, E, tid); }
            PH_END
            PH_BEGIN
            { pg8::Gemm g{HID, wl + WO_DOWN, DFF, DFF}; pg8::StaticOrder S; S.init(TG, DM, G, bx);
              pg8::Epi<pg8::EP_STORE> E{}; E.O = Y; E.ldc = DM;
              pg8::gemm_phase<pg8::Epi<pg8::EP_STORE>, pg8::StaticOrder, true, true>(ldsl, g, S, E, tid); }
            PH_END
        }
        PH_BEGIN
        resid_rows(nullptr, HN, Y, PIN(I_LFPOST) + 3 * DM, nullptr, xout, TG, gw, NGW, lane);
        PH_END
    }
}

extern "C" void kernel_launch(void* const* d_in, const int* in_sizes, int n_in, void* d_out, int out_size, void* d_ws, size_t ws_size, hipStream_t stream) {
    static int grid = 0;
    if (grid == 0) {
        if (n_in != 24 || out_size != 98304 * 1024 || ws_size < WS_END) { fprintf(stderr, "kernel_launch: unexpected shapes: n_in %d out %d ws %zu (need %zu)\n", n_in, out_size, ws_size, (size_t)WS_END); grid = -1; return; }
        int dev = 0, cus = 0, per_cu = 0;
        hipGetDevice(&dev); hipDeviceGetAttribute(&cus, hipDeviceAttributeMultiprocessorCount, dev);
        if (hipFuncSetAttribute((const void*)fwd_megakernel, hipFuncAttributeMaxDynamicSharedMemorySize, LDS_BYTES) != hipSuccess) { fprintf(stderr, "kernel_launch: hipFuncSetAttribute failed\n"); grid = -1; return; }
        if (hipOccupancyMaxActiveBlocksPerMultiprocessor(&per_cu, (const void*)fwd_megakernel, 512, LDS_BYTES) != hipSuccess || per_cu < 1) { fprintf(stderr, "kernel_launch: occupancy query says %d\n", per_cu); per_cu = 1; }
        (void)hipGetLastError();
        grid = cus * per_cu;
    }
    if (grid < 0) return;
    if (hipMemsetAsync(d_ws, 0, 65536, stream) != hipSuccess) { fprintf(stderr, "kernel_launch: hipMemsetAsync failed\n"); return; }
    Params p{};
    for (int i = 0; i < 24; ++i) p.in[i] = (const float*)d_in[i];
    p.out = (float*)d_out; p.ws = (unsigned char*)d_ws; p.ph_lo = 0; p.ph_hi = 1 << 30;
    void* args[] = {&p};
    hipError_t e = hipLaunchCooperativeKernel((const void*)fwd_megakernel, dim3(grid), dim3(512), args, LDS_BYTES, stream);
    if (e != hipSuccess) fprintf(stderr, "cooperative launch failed: %s (grid %d)\n", hipGetErrorString(e), grid);
}
```

```cpp
#include <hip/hip_runtime.h>
#include <hip/hip_cooperative_groups.h>
#include <hip/hip_bf16.h>
#include <cstdio>
#include <cstdint>
namespace cg = cooperative_groups;

constexpr int DM = 1024, NL = 4, TG = 32768, NGRP = 3, NMG = TG / 256;
constexpr int INW = 1696, INP = 1792;
constexpr int Z_CQ = 512, Z_CKV = 896, Z_KR = 1152, Z_QX = 1184;
constexpr int QL = 384, KVL = 256, NH = 8, QKD = 96, VD = 64, QW = NH * QKD, VW = NH * VD;
constexpr int DFF = 2816, NMEMROWS = 6144;
constexpr float EPS = 1e-6f;
constexpr size_t WO_IN = 0, WO_GATE = WO_IN + (size_t)INP * 1024, WO_UQ = WO_GATE + (size_t)3072 * 1024, WO_UKV = WO_UQ + (size_t)768 * 384,
                 WO_POOL = WO_UKV + (size_t)1024 * 256, WO_BR = WO_POOL + (size_t)512 * 512, WO_OUT = WO_BR + (size_t)3072 * 512,
                 WO_GU = WO_OUT + (size_t)1024 * 1024, WO_DOWN = WO_GU + (size_t)5632 * 1024, W_LAYER = WO_DOWN + (size_t)1024 * 2816;
constexpr size_t MiB = 1u << 20;
constexpr size_t WS_ROPE = 1 * MiB;
constexpr size_t WS_MEMB = 2 * MiB;
constexpr size_t WS_KVMEM = 16 * MiB;
constexpr size_t WS_W = 68 * MiB;
constexpr size_t WS_WMEM = WS_W + 4 * W_LAYER * 2;
constexpr size_t WS_ACT = 216 * MiB;
static_assert(WS_WMEM + (size_t)4096 * 1024 * 2 <= WS_ACT, "weights fit");
constexpr size_t A_R1 = WS_ACT;
constexpr size_t A_Z = A_R1, A_DIFF = A_Z + (size_t)TG * INP * 2, A_Q = A_DIFF + (size_t)TG * 512 * 2;
constexpr size_t A_BR = A_R1, A_HID = A_R1;
constexpr size_t A_HN = A_R1 + 192 * MiB;
constexpr size_t A_K = A_HN + 64 * MiB;
constexpr size_t A_V = A_K + 48 * MiB;
constexpr size_t A_BRIN = A_V + 32 * MiB;
constexpr size_t A_MERGED = A_BRIN + 96 * MiB;
constexpr size_t A_Y = A_MERGED + 64 * MiB;
constexpr size_t A_RQ = A_Y + 64 * MiB;
constexpr size_t A_MPART = A_RQ + 1 * MiB;
constexpr size_t WS_END = A_MPART + 64 * MiB;
static_assert(A_Q + (size_t)TG * QW * 2 <= A_HN && (size_t)TG * 3072 * 2 <= 192 * MiB && (size_t)TG * DFF * 2 <= 192 * MiB, "R1 overlay");
static_assert(WS_END <= (size_t)1024 * MiB, "workspace");
constexpr int LDS_BYTES = 147456;

namespace pg8 {
#define GAS __attribute__((address_space(1)))
#define PG8_LAS __attribute__((address_space(3)))
typedef unsigned short bf16_t;
typedef short bf16x8 __attribute__((ext_vector_type(8)));
typedef float f32x4 __attribute__((ext_vector_type(4)));
typedef unsigned u32x4 __attribute__((ext_vector_type(4)));
constexpr int BM = 256, BK = 64, HALF = 128, HTB = HALF * BK * 2  , STAGE_BYTES = 8 * HTB, NXCD = 8, WGM = 8;

__host__ __device__ __forceinline__ int lds_byte(int r, int c) { const int st = (r >> 4) * 2 + (c >> 5), rr = r & 15, cc = c & 31, ob = rr * 64 + cc * 2; return st * 1024 + (ob ^ (((ob >> 9) & 1) << 5)); }
__host__ __device__ __forceinline__ void stage_rc(int b, int& R, int& C) { const int st = b / 1024, sb = b % 1024, swz = sb ^ (((sb >> 9) & 1) << 5); R = (st >> 1) * 16 + swz / 64; C = (st & 1) * 32 + (swz % 64) / 2; }
__host__ __device__ __forceinline__ int perm32(int rho) { const int n = rho >> 4, i = rho & 15; return 8 * (i >> 2) + 4 * n + (i & 3); }

struct Unit { int pm, pn; };
struct Gemm { const bf16_t* A; const bf16_t* Bt; int lda, K; };

struct StaticOrder {
    int nM, nN, nwg, G, c;
    __host__ __device__ void init(int M, int N, int G_, int c_) { nM = M / BM; nN = N / BM; nwg = nM * nN; G = G_; c = c_; }
    __host__ __device__ bool next(int i, Unit& u) const { return at((long)i * G + c, u); }
    __host__ __device__ bool at(long L, Unit& u) const {
        if (L >= nwg) return false;
        int wgid = (int)L; { const int q = nwg / NXCD, r = nwg % NXCD, xcd = wgid % NXCD, off = wgid / NXCD; wgid = (xcd < r ? xcd * (q + 1) : r * (q + 1) + (xcd - r) * q) + off; }
        const int nig = WGM * nN, gid = wgid / nig, fm = gid * WGM, gsz = (nM - fm) < WGM ? (nM - fm) : WGM;
        u.pm = fm + ((wgid % nig) % gsz); u.pn = (wgid % nig) / gsz; return true;
    }
    __device__ __forceinline__ void a_ready(const Unit&) const {}
    __device__ __forceinline__ void done(const Unit&) const {}
};

struct GateOrder {
    StaticOrder B;
    __device__ void init(int M, int G_, int c_) { B.init(M, 1024, G_, c_); }
    __device__ bool next(int i, Unit& u) const { Unit t; if (!B.next(i / 3, t)) return false; u.pm = t.pm; u.pn = (i % 3) * 4 + t.pn; return true; }
    __device__ __forceinline__ void a_ready(const Unit&) const {}
    __device__ __forceinline__ void done(const Unit&) const {}
};
struct BranchOrder {
    StaticOrder B; int nM;
    __device__ void init(int M, int G_, int c_) { B.init(M, 3072, G_, c_); nM = M / BM; }
    __device__ bool next(int i, Unit& u) const { if (!B.next(i, u)) return false; u.pm += (u.pn >> 2) * nM; return true; }
    __device__ __forceinline__ void a_ready(const Unit&) const {}
    __device__ __forceinline__ void done(const Unit&) const {}
};

__device__ __forceinline__ unsigned cvt_pk_bf16(float lo, float hi) { unsigned r; asm volatile("v_cvt_pk_bf16_f32 %0, %1, %2" : "=v"(r) : "v"(lo), "v"(hi)); return r; }
__device__ __forceinline__ float bf_lo(unsigned w) { return __uint_as_float(w << 16); }
__device__ __forceinline__ float bf_hi(unsigned w) { return __uint_as_float(w & 0xffff0000u); }
__device__ __forceinline__ float sigmoidf_(float x) { return __builtin_amdgcn_rcpf(1.0f + __builtin_amdgcn_exp2f(-1.4426950408889634f * x)); }
__device__ __forceinline__ u32x4 pack8(const f32x4& a, const f32x4& b) { u32x4 w; w.x = cvt_pk_bf16(a[0], a[1]); w.y = cvt_pk_bf16(a[2], a[3]); w.z = cvt_pk_bf16(b[0], b[1]); w.w = cvt_pk_bf16(b[2], b[3]); return w; }

enum { EP_STORE = 0, EP_Q = 1, EP_KV = 2, EP_BR = 3, EP_GATE = 4, EP_SWIGLU = 5, EP_G2 = 6 };
template <int MODE> struct Epi {
    static constexpr bool PERM = true, AFTER_DRAIN = false;
    bf16_t* O; int ldc;
    bf16_t* O2;
    const float* rs;
    const float* cs; const float* sn;
    int seqmask;
    int nM;
    bf16_t* O3;
    bf16_t* O4;
    const float* rs2;
    __device__ __forceinline__ void operator()(const f32x4 (&acc)[2][2][4][2], const Unit& u, int wr, int wc, int fr_, int fq_) const {
        int z_ = 0; asm volatile("" : "+v"(z_)); const int ln_ = __builtin_amdgcn_mbcnt_hi(-1, __builtin_amdgcn_mbcnt_lo(-1, z_)), fr = ln_ & 15, fq = ln_ >> 4;
        (void)fr_; (void)fq_; const int wv_ = wr * 4 + wc; (void)wv_;
        const int pm = (MODE == EP_BR) ? (u.pm % nM) : u.pm;
        const int kind = (MODE == EP_G2) ? (u.pn < 3 ? 0 : (u.pn < 7 ? 1 : 2)) : 0;
        const int pnl = (MODE == EP_G2) ? (kind == 0 ? u.pn : (kind == 1 ? u.pn - 3 : u.pn - 7)) : u.pn;
        const int row0 = pm * BM + wr * 64 + fr, colt = pnl * BM + wc * 32 + 8 * fq;
        if constexpr (MODE == EP_SWIGLU) {
            const int hc = u.pn * 128 + wc * 32 + 8 * fq;
#pragma unroll
            for (int ai = 0; ai < 2; ++ai)
#pragma unroll
                for (int m = 0; m < 4; ++m) { const int row = row0 + ai * HALF + m * 16; f32x4 h0, h1; const float rr = ((const GAS float*)rs2)[row];
#pragma unroll
                    for (int j = 0; j < 4; ++j) { const float g0 = acc[ai][0][m][0][j] * rr, g1 = acc[ai][0][m][1][j] * rr;
                        h0[j] = g0 * sigmoidf_(g0) * (acc[ai][1][m][0][j] * rr); h1[j] = g1 * sigmoidf_(g1) * (acc[ai][1][m][1][j] * rr); }
                    *(GAS u32x4*)(O + (size_t)row * ldc + hc) = pack8(h0, h1); }
        } else {
#pragma unroll
            for (int ai = 0; ai < 2; ++ai)
#pragma unroll
                for (int m = 0; m < 4; ++m) { const int row = row0 + ai * HALF + m * 16;
                    float sc = 1.f; if constexpr (MODE == EP_Q || MODE == EP_KV) sc = ((const GAS float*)rs)[row]; if constexpr (MODE == EP_GATE) { if (u.pn < 12) sc = ((const GAS float*)rs2)[row]; }
                    if constexpr (MODE == EP_G2) { if (kind == 0) sc = ((const GAS float*)rs)[row]; else if (kind == 1) sc = ((const GAS float*)rs2)[row]; }
#pragma unroll
                    for (int bj = 0; bj < 2; ++bj) { const int col = colt + bj * HALF; f32x4 v0 = acc[ai][bj][m][0] * sc, v1 = acc[ai][bj][m][1] * sc;
                        if constexpr (MODE == EP_STORE) { *(GAS u32x4*)(O + (size_t)row * ldc + col) = pack8(v0, v1); }
                        else if constexpr (MODE == EP_BR) {
                            ((GAS u32x4*)O)[((size_t)((((pm * 12 + u.pn) * 2 + ai) * 4 + m) * 2 + bj)) * 512 + wv_ * 64 + ln_] = pack8(v0, v1); }
                        else if constexpr (MODE == EP_Q) { *(GAS u32x4*)(O + (size_t)row * ldc + col) = pack8(v0, v1); }
                        else if constexpr (MODE == EP_G2) {
                            if (kind == 0) *(GAS u32x4*)(O + (size_t)row * QW + col) = pack8(v0, v1);
                            else if (kind == 1) { if (col < 512) *(GAS u32x4*)(O2 + (size_t)row * QW + (col >> 6) * QKD + (col & 63)) = pack8(v0, v1); else *(GAS u32x4*)(O3 + (size_t)row * VW + (col - 512)) = pack8(v0, v1); }
                            else *(GAS u32x4*)(O4 + (size_t)row * 512 + col) = pack8(v0, v1); }
                        else if constexpr (MODE == EP_KV) {
                            if (col < 512) *(GAS u32x4*)(O + (size_t)row * QW + (col >> 6) * QKD + (col & 63)) = pack8(v0, v1);
                            else *(GAS u32x4*)(O2 + (size_t)row * VW + (col - 512)) = pack8(v0, v1); }
                        else if constexpr (MODE == EP_GATE) {
                            GAS u32x4* brs = (GAS u32x4*)O2 + ((size_t)((ai * 4 + m) * 2 + bj)) * 512 + wv_ * 64 + ln_;
                            if (u.pn >= 12) { *brs = pack8(v0, v1); continue; }
                            const int n = u.pn >> 2, d = col - n * 1024;
                            const f32x4 b0 = *(const GAS f32x4*)(rs + col), b1 = *(const GAS f32x4*)(rs + col + 4);
                            const u32x4 br = *brs;
                            f32x4 r0, r1;
                            r0[0] = sigmoidf_(v0[0] + b0[0]) * bf_lo(br.x); r0[1] = sigmoidf_(v0[1] + b0[1]) * bf_hi(br.x); r0[2] = sigmoidf_(v0[2] + b0[2]) * bf_lo(br.y); r0[3] = sigmoidf_(v0[3] + b0[3]) * bf_hi(br.y);
                            r1[0] = sigmoidf_(v1[0] + b1[0]) * bf_lo(br.z); r1[1] = sigmoidf_(v1[1] + b1[1]) * bf_hi(br.z); r1[2] = sigmoidf_(v1[2] + b1[2]) * bf_lo(br.w); r1[3] = sigmoidf_(v1[3] + b1[3]) * bf_hi(br.w);
                            GAS u32x4* mpart = (GAS u32x4*)O3 + ((size_t)((((pm * 4 + (u.pn & 3)) * 2 + ai) * 4 + m) * 2 + bj)) * 512 + wv_ * 64 + ln_;
                            if (n > 0) { const u32x4 pv = *mpart;
                                r0[0] += bf_lo(pv.x); r0[1] += bf_hi(pv.x); r0[2] += bf_lo(pv.y); r0[3] += bf_hi(pv.y); r1[0] += bf_lo(pv.z); r1[1] += bf_hi(pv.z); r1[2] += bf_lo(pv.w); r1[3] += bf_hi(pv.w); }
                            if (n < 2) *mpart = pack8(r0, r1); else *(GAS u32x4*)(O + (size_t)row * ldc + d) = pack8(r0, r1); }
                    } }
        }
    }
};

template <class Epi, class Sched, bool ALIGN_EPI = false, bool SP2 = false>
__device__ __forceinline__ void gemm_phase(PG8_LAS unsigned char* lds, const Gemm g, const Sched& S, const Epi& E, int tid_in) {
    int tid_ = tid_in; asm volatile("" : "+v"(tid_));
    const int tid = tid_, wid = __builtin_amdgcn_readfirstlane(tid >> 6), lane = tid & 63, wr = wid >> 2, wc = wid & 3, fr = lane & 15, fq = lane >> 4;
    const int K = g.K, nt = K / BK;
    unsigned voffA[2], voffB[2];
#pragma unroll
    for (int i = 0; i < 2; ++i) { int R, C; stage_rc(tid * 16 + i * 8192, R, C); const int Rb = Epi::PERM ? ((R & ~31) + perm32(R & 31)) : R;
        voffA[i] = (unsigned)(R * g.lda + C) * 2u; voffB[i] = (unsigned)(Rb * K + C) * 2u; }
    const size_t kstep = (size_t)(BK * 2);
    const size_t hstepA = (size_t)HALF * g.lda * 2, hstepB = (size_t)HALF * K * 2;
    const size_t tstepA = 2 * hstepA, tstepB = 2 * hstepB;
    const unsigned ldsw = (unsigned)wid * 1024u;
    const int aoff = lds_byte(wr * 64 + fr, fq * 8), boff = lds_byte(wc * 32 + fr, fq * 8);
#define PG8_SA(b, h) (((b) * 2 + (h)) * HTB)
#define PG8_SB(b, h) ((4 + (b) * 2 + (h)) * HTB)
#define PG8_STAGE(bufoff, gbase, voff) do { _Pragma("unroll") for (int _i = 0; _i < 2; ++_i) \
        __builtin_amdgcn_global_load_lds((const unsigned*)((const char*)(gbase) + (voff)[_i]), (PG8_LAS unsigned*)(lds + (bufoff) + ldsw + _i * 8192), 16, 0, 0); } while (0)
#define PG8_LDA(dst, b, h) do { _Pragma("unroll") for (int m = 0; m < 4; ++m) _Pragma("unroll") for (int k = 0; k < 2; ++k) dst[m][k] = *(const PG8_LAS bf16x8*)(lds + PG8_SA(b, h) + aoff + m * 2048 + k * 1024); } while (0)
#define PG8_LDB(dst, b, h) do { _Pragma("unroll") for (int n = 0; n < 2; ++n) _Pragma("unroll") for (int k = 0; k < 2; ++k) dst[n][k] = *(const PG8_LAS bf16x8*)(lds + PG8_SB(b, h) + boff + n * 2048 + k * 1024); } while (0)
#define PG8_MMA(ai, bj, At, Bt) do { __builtin_amdgcn_s_setprio(1); _Pragma("unroll") for (int m = 0; m < 4; ++m) _Pragma("unroll") for (int n = 0; n < 2; ++n) _Pragma("unroll") for (int k = 0; k < 2; ++k) \
        acc[ai][bj][m][n] = __builtin_amdgcn_mfma_f32_16x16x32_bf16(Bt[n][k], At[m][k], acc[ai][bj][m][n], 0, 0, 0); __builtin_amdgcn_s_setprio(0); } while (0)
#define PG8_WAIT_V(n) asm volatile("s_waitcnt vmcnt(" #n ")" ::: "memory")
#define PG8_WAIT_L(n) asm volatile("s_waitcnt lgkmcnt(" #n ")" ::: "memory")
#define PG8_BAR __builtin_amdgcn_s_barrier()
#define PG8_SCHED __builtin_amdgcn_sched_barrier(0)
    Unit cur, nxt; int ui = 0;
    if (!S.next(0, cur)) return;
    f32x4 acc[2][2][4][2];
#pragma unroll
    for (int a = 0; a < 2; ++a)
#pragma unroll
        for (int b = 0; b < 2; ++b)
#pragma unroll
            for (int m = 0; m < 4; ++m)
#pragma unroll
                for (int n = 0; n < 2; ++n) acc[a][b][m][n] = (f32x4){0.f, 0.f, 0.f, 0.f};
    bf16x8 At[4][2], B0[2][2], B1[2][2];
    const char* cA = (const char*)g.A + (size_t)cur.pm * tstepA; const char* cB = (const char*)g.Bt + (size_t)cur.pn * tstepB;
    S.a_ready(cur);
    if constexpr (SP2) {
        PG8_STAGE(PG8_SB(0, 0), cB, voffB); PG8_STAGE(PG8_SB(0, 1), cB + hstepB, voffB); PG8_STAGE(PG8_SA(0, 0), cA, voffA); PG8_STAGE(PG8_SA(0, 1), cA + hstepA, voffA);
        if (wr == 1) PG8_BAR;
        PG8_WAIT_V(2); PG8_BAR;
        PG8_STAGE(PG8_SB(1, 0), cB + kstep, voffB); PG8_STAGE(PG8_SA(1, 0), cA + kstep, voffA); PG8_STAGE(PG8_SB(1, 1), cB + hstepB + kstep, voffB);
        PG8_WAIT_V(6); PG8_BAR;
    } else {
        PG8_STAGE(PG8_SB(0, 0), cB, voffB); PG8_STAGE(PG8_SA(0, 0), cA, voffA); PG8_STAGE(PG8_SB(0, 1), cB + hstepB, voffB); PG8_STAGE(PG8_SA(0, 1), cA + hstepA, voffA);
        if (wr == 1) PG8_BAR;
        PG8_WAIT_V(4); PG8_BAR;
        PG8_STAGE(PG8_SB(1, 0), cB + kstep, voffB); PG8_STAGE(PG8_SA(1, 0), cA + kstep, voffA); PG8_STAGE(PG8_SB(1, 1), cB + hstepB + kstep, voffB);
        PG8_WAIT_V(6); PG8_BAR;
    }
    for (;;) {
        const bool has_next = S.next(ui + 1, nxt);
        const char* nA = has_next ? (const char*)g.A + (size_t)nxt.pm * tstepA : cA; const char* nB = has_next ? (const char*)g.Bt + (size_t)nxt.pn * tstepB : cB;
        for (int t = 0; t < nt; t += 2) {
            const bool last = (t == nt - 2);
            const char* a1 = cA + (size_t)(t + 1) * kstep;
            const char* a2 = last ? nA : cA + (size_t)(t + 2) * kstep; const char* b2 = last ? nB : cB + (size_t)(t + 2) * kstep;
            const char* a3 = a2 + kstep; const char* b3 = b2 + kstep;
            if (last && has_next) S.a_ready(nxt);
            if constexpr (SP2) {
            PG8_LDB(B0, 0, 0); PG8_LDB(B1, 0, 1); PG8_SCHED; PG8_LDA(At, 0, 0); PG8_STAGE(PG8_SA(1, 1), a1 + hstepA, voffA);
            PG8_WAIT_V(8); PG8_WAIT_L(0); PG8_BAR; PG8_MMA(0, 0, At, B0); PG8_MMA(0, 1, At, B1); PG8_BAR; PG8_SCHED;
            PG8_LDA(At, 0, 1); PG8_STAGE(PG8_SB(0, 0), b2, voffB); PG8_STAGE(PG8_SB(0, 1), b2 + hstepB, voffB); PG8_STAGE(PG8_SA(0, 0), a2, voffA);
            PG8_WAIT_V(8); PG8_WAIT_L(0); PG8_BAR; PG8_MMA(1, 0, At, B0); PG8_MMA(1, 1, At, B1); PG8_BAR; PG8_SCHED;
            PG8_LDB(B0, 1, 0); PG8_LDB(B1, 1, 1); PG8_SCHED; PG8_LDA(At, 1, 0); PG8_STAGE(PG8_SA(0, 1), a2 + hstepA, voffA);
            PG8_WAIT_V(8); PG8_WAIT_L(0); PG8_BAR; PG8_MMA(0, 0, At, B0); PG8_MMA(0, 1, At, B1); PG8_BAR; PG8_SCHED;
            PG8_LDA(At, 1, 1); PG8_STAGE(PG8_SB(1, 0), b3, voffB); PG8_STAGE(PG8_SB(1, 1), b3 + hstepB, voffB); PG8_STAGE(PG8_SA(1, 0), a3, voffA);
            PG8_WAIT_V(8); PG8_WAIT_L(0); PG8_BAR; PG8_MMA(1, 0, At, B0); PG8_MMA(1, 1, At, B1); PG8_BAR; PG8_SCHED;
            } else {
            PG8_LDB(B0, 0, 0); PG8_SCHED; PG8_LDA(At, 0, 0); PG8_STAGE(PG8_SA(1, 1), a1 + hstepA, voffA);
            PG8_WAIT_L(8); PG8_BAR; PG8_WAIT_L(0); PG8_MMA(0, 0, At, B0); PG8_BAR; PG8_SCHED;
            PG8_LDB(B1, 0, 1); PG8_STAGE(PG8_SB(0, 0), b2, voffB);
            PG8_BAR; PG8_WAIT_L(0); PG8_MMA(0, 1, At, B1); PG8_BAR;
            PG8_LDA(At, 0, 1); PG8_STAGE(PG8_SA(0, 0), a2, voffA);
            PG8_BAR; PG8_WAIT_L(0); PG8_MMA(1, 0, At, B0); PG8_BAR; PG8_SCHED;
            PG8_STAGE(PG8_SB(0, 1), b2 + hstepB, voffB);
            PG8_WAIT_V(6); PG8_BAR; PG8_MMA(1, 1, At, B1); PG8_BAR;
            PG8_LDB(B0, 1, 0); PG8_SCHED; PG8_LDA(At, 1, 0); PG8_STAGE(PG8_SA(0, 1), a2 + hstepA, voffA);
            PG8_WAIT_L(8); PG8_BAR; PG8_WAIT_L(0); PG8_MMA(0, 0, At, B0); PG8_BAR; PG8_SCHED;
            PG8_LDB(B1, 1, 1); PG8_STAGE(PG8_SB(1, 0), b3, voffB);
            PG8_BAR; PG8_WAIT_L(0); PG8_MMA(0, 1, At, B1); PG8_BAR;
            PG8_LDA(At, 1, 1); PG8_STAGE(PG8_SA(1, 0), a3, voffA);
            PG8_BAR; PG8_WAIT_L(0); PG8_MMA(1, 0, At, B0); PG8_BAR; PG8_SCHED;
            PG8_STAGE(PG8_SB(1, 1), b3 + hstepB, voffB);
            PG8_WAIT_V(6); PG8_BAR; PG8_MMA(1, 1, At, B1); PG8_BAR;
            }
        }
        if constexpr (ALIGN_EPI) { if (wr == 0) PG8_BAR; }
        if constexpr (!Epi::AFTER_DRAIN) { E(acc, cur, wr, wc, fr, fq); S.done(cur); }
        if (!has_next) break;
#pragma unroll
        for (int a = 0; a < 2; ++a)
#pragma unroll
            for (int b = 0; b < 2; ++b)
#pragma unroll
                for (int m = 0; m < 4; ++m)
#pragma unroll
                    for (int n = 0; n < 2; ++n) acc[a][b][m][n] = (f32x4){0.f, 0.f, 0.f, 0.f};
        cur = nxt; cA = nA; cB = nB; ++ui;
        if constexpr (ALIGN_EPI) { if (wr == 1) PG8_BAR; }
    }
    PG8_WAIT_V(0);
    if constexpr (!ALIGN_EPI) { if (wr == 0) PG8_BAR; }
    PG8_BAR;
    if constexpr (Epi::AFTER_DRAIN) { E.fused(acc, cur, wr, wc, fr, fq, lds, wid, lane); S.done(cur); }
#undef PG8_SA
#undef PG8_SB
#undef PG8_STAGE
#undef PG8_LDA
#undef PG8_LDB
#undef PG8_MMA
#undef PG8_WAIT_V
#undef PG8_WAIT_L
#undef PG8_BAR
#undef PG8_SCHED
}

struct Desc { const char* A; const char* B; int lda, K; };
template <class Epi, class Sched>
__device__ __forceinline__ void gemm_phase_vk(PG8_LAS unsigned char* lds, const Sched& S, const Epi& E, int tid_in) {
    int tid_ = tid_in; asm volatile("" : "+v"(tid_));
    const int tid = tid_, wid = __builtin_amdgcn_readfirstlane(tid >> 6), lane = tid & 63, wr = wid >> 2, wc = wid & 3, fr = lane & 15, fq = lane >> 4;
    int RA[2], RB[2]; unsigned C2[2];
#pragma unroll
    for (int i = 0; i < 2; ++i) { int R, C; stage_rc(tid * 16 + i * 8192, R, C); RA[i] = R; RB[i] = Epi::PERM ? ((R & ~31) + perm32(R & 31)) : R; C2[i] = (unsigned)C * 2u; }
    const size_t kstep = (size_t)(BK * 2);
    const unsigned ldsw = (unsigned)wid * 1024u;
    const int aoff = lds_byte(wr * 64 + fr, fq * 8), boff = lds_byte(wc * 32 + fr, fq * 8);
#define PG8_SA(b, h) (((b) * 2 + (h)) * HTB)
#define PG8_SB(b, h) ((4 + (b) * 2 + (h)) * HTB)
#define PG8_STAGE(bufoff, gbase, voff) do { _Pragma("unroll") for (int _i = 0; _i < 2; ++_i) \
        __builtin_amdgcn_global_load_lds((const unsigned*)((const char*)(gbase) + (voff)[_i]), (PG8_LAS unsigned*)(lds + (bufoff) + ldsw + _i * 8192), 16, 0, 0); } while (0)
#define PG8_LDA(dst, b, h) do { _Pragma("unroll") for (int m = 0; m < 4; ++m) _Pragma("unroll") for (int k = 0; k < 2; ++k) dst[m][k] = *(const PG8_LAS bf16x8*)(lds + PG8_SA(b, h) + aoff + m * 2048 + k * 1024); } while (0)
#define PG8_LDB(dst, b, h) do { _Pragma("unroll") for (int n = 0; n < 2; ++n) _Pragma("unroll") for (int k = 0; k < 2; ++k) dst[n][k] = *(const PG8_LAS bf16x8*)(lds + PG8_SB(b, h) + boff + n * 2048 + k * 1024); } while (0)
#define PG8_MMA(ai, bj, At, Bt) do { __builtin_amdgcn_s_setprio(1); _Pragma("unroll") for (int m = 0; m < 4; ++m) _Pragma("unroll") for (int n = 0; n < 2; ++n) _Pragma("unroll") for (int k = 0; k < 2; ++k) \
        acc[ai][bj][m][n] = __builtin_amdgcn_mfma_f32_16x16x32_bf16(Bt[n][k], At[m][k], acc[ai][bj][m][n], 0, 0, 0); __builtin_amdgcn_s_setprio(0); } while (0)
#define PG8_WAIT_V(n) asm volatile("s_waitcnt vmcnt(" #n ")" ::: "memory")
#define PG8_WAIT_L(n) asm volatile("s_waitcnt lgkmcnt(" #n ")" ::: "memory")
#define PG8_BAR __builtin_amdgcn_s_barrier()
#define PG8_SCHED __builtin_amdgcn_sched_barrier(0)
#define VK_SETV(vA, vB, d) do { _Pragma("unroll") for (int _i = 0; _i < 2; ++_i) { vA[_i] = (unsigned)(RA[_i] * (d).lda) * 2u + C2[_i]; vB[_i] = (unsigned)(RB[_i] * (d).K) * 2u + C2[_i]; } } while (0)
    Unit cur, nxt; int ui = 0;
    if (!S.next(0, cur)) return;
    Desc dc = S.desc(cur), dn = dc;
    f32x4 acc[2][2][4][2];
#pragma unroll
    for (int a = 0; a < 2; ++a)
#pragma unroll
        for (int b = 0; b < 2; ++b)
#pragma unroll
            for (int m = 0; m < 4; ++m)
#pragma unroll
                for (int n = 0; n < 2; ++n) acc[a][b][m][n] = (f32x4){0.f, 0.f, 0.f, 0.f};
    bf16x8 At[4][2], B0[2][2], B1[2][2];
    unsigned vAc[2], vBc[2], vAn[2], vBn[2];
    VK_SETV(vAc, vBc, dc);
    size_t hAc = (size_t)HALF * dc.lda * 2, hBc = (size_t)HALF * dc.K * 2, hAn = hAc, hBn = hBc;
    const char* cA = dc.A; const char* cB = dc.B; int ntc = dc.K / BK;
    PG8_STAGE(PG8_SB(0, 0), cB, vBc); PG8_STAGE(PG8_SB(0, 1), cB + hBc, vBc); PG8_STAGE(PG8_SA(0, 0), cA, vAc); PG8_STAGE(PG8_SA(0, 1), cA + hAc, vAc);
    if (wr == 1) PG8_BAR;
    PG8_WAIT_V(2); PG8_BAR;
    PG8_STAGE(PG8_SB(1, 0), cB + kstep, vBc); PG8_STAGE(PG8_SA(1, 0), cA + kstep, vAc); PG8_STAGE(PG8_SB(1, 1), cB + hBc + kstep, vBc);
    PG8_WAIT_V(6); PG8_BAR;
    for (;;) {
        const bool has_next = S.next(ui + 1, nxt);
        if (has_next) dn = S.desc(nxt); else dn = dc;
        VK_SETV(vAn, vBn, dn); hAn = (size_t)HALF * dn.lda * 2; hBn = (size_t)HALF * dn.K * 2;
        const char* nA = dn.A; const char* nB = dn.B;
        for (int t = 0; t < ntc; t += 2) {
            const bool last = (t == ntc - 2);
            const char* a1 = cA + (size_t)(t + 1) * kstep;
            const char* a2 = last ? nA : cA + (size_t)(t + 2) * kstep; const char* b2 = last ? nB : cB + (size_t)(t + 2) * kstep;
            const char* a3 = a2 + kstep; const char* b3 = b2 + kstep;
            unsigned vA2[2], vB2[2]; vA2[0] = last ? vAn[0] : vAc[0]; vA2[1] = last ? vAn[1] : vAc[1]; vB2[0] = last ? vBn[0] : vBc[0]; vB2[1] = last ? vBn[1] : vBc[1];
            const size_t hA2 = last ? hAn : hAc, hB2 = last ? hBn : hBc;
            PG8_LDB(B0, 0, 0); PG8_LDB(B1, 0, 1); PG8_SCHED; PG8_LDA(At, 0, 0); PG8_STAGE(PG8_SA(1, 1), a1 + hAc, vAc);
            PG8_WAIT_V(8); PG8_WAIT_L(0); PG8_BAR; PG8_MMA(0, 0, At, B0); PG8_MMA(0, 1, At, B1); PG8_BAR; PG8_SCHED;
            PG8_LDA(At, 0, 1); PG8_STAGE(PG8_SB(0, 0), b2, vB2); PG8_STAGE(PG8_SB(0, 1), b2 + hB2, vB2); PG8_STAGE(PG8_SA(0, 0), a2, vA2);
            PG8_WAIT_V(8); PG8_WAIT_L(0); PG8_BAR; PG8_MMA(1, 0, At, B0); PG8_MMA(1, 1, At, B1); PG8_BAR; PG8_SCHED;
            PG8_LDB(B0, 1, 0); PG8_LDB(B1, 1, 1); PG8_SCHED; PG8_LDA(At, 1, 0); PG8_STAGE(PG8_SA(0, 1), a2 + hA2, vA2);
            PG8_WAIT_V(8); PG8_WAIT_L(0); PG8_BAR; PG8_MMA(0, 0, At, B0); PG8_MMA(0, 1, At, B1); PG8_BAR; PG8_SCHED;
            PG8_LDA(At, 1, 1); PG8_STAGE(PG8_SB(1, 0), b3, vB2); PG8_STAGE(PG8_SB(1, 1), b3 + hB2, vB2); PG8_STAGE(PG8_SA(1, 0), a3, vA2);
            PG8_WAIT_V(8); PG8_WAIT_L(0); PG8_BAR; PG8_MMA(1, 0, At, B0); PG8_MMA(1, 1, At, B1); PG8_BAR; PG8_SCHED;
        }
        if (wr == 0) PG8_BAR;
        E(acc, cur, wr, wc, fr, fq);
        if (!has_next) break;
#pragma unroll
        for (int a = 0; a < 2; ++a)
#pragma unroll
            for (int b = 0; b < 2; ++b)
#pragma unroll
                for (int m = 0; m < 4; ++m)
#pragma unroll
                    for (int n = 0; n < 2; ++n) acc[a][b][m][n] = (f32x4){0.f, 0.f, 0.f, 0.f};
        cur = nxt; dc = dn; cA = nA; cB = nB; ntc = dn.K / BK; hAc = hAn; hBc = hBn; vAc[0] = vAn[0]; vAc[1] = vAn[1]; vBc[0] = vBn[0]; vBc[1] = vBn[1]; ++ui;
        if (wr == 1) PG8_BAR;
    }
    PG8_WAIT_V(0);
    PG8_BAR;
#undef VK_SETV
#undef PG8_SA
#undef PG8_SB
#undef PG8_STAGE
#undef PG8_LDA
#undef PG8_LDB
#undef PG8_MMA
#undef PG8_WAIT_V
#undef PG8_WAIT_L
#undef PG8_BAR
#undef PG8_SCHED
}
struct GBOrder {
    StaticOrder B; const char* XBp; const char* WGp; const char* BRINp; const char* WBRp; size_t brin_n_stride;
    __device__ void init(int M, int G_, int c_) { B.init(M, 1024, G_, c_); }
    __device__ bool next(int i, Unit& u) const { Unit t; if (!B.next(i / 6, t)) return false; const int r = i % 6, n = r >> 1; u.pm = t.pm; u.pn = ((r & 1) ? 0 : 12) + n * 4 + t.pn; return true; }
    __device__ __forceinline__ Desc desc(const Unit& u) const {
        Desc d; if (u.pn < 12) { d.A = XBp + (size_t)u.pm * 256 * 1024 * 2; d.B = WGp + (size_t)u.pn * 256 * 1024 * 2; d.lda = 1024; d.K = 1024; }
        else { const int q = u.pn - 12; d.A = BRINp + (size_t)(q >> 2) * brin_n_stride + (size_t)u.pm * 256 * 512 * 2; d.B = WBRp + (size_t)q * 256 * 512 * 2; d.lda = 512; d.K = 512; }
        return d; }
};

struct G2Order {
    StaticOrder Sp, Sk, Sq; int G, c; const char* Zp; const char* DIFFp; const char* Wq; const char* Wkv; const char* Wp;
    __device__ void init(int M, int G_, int c_) { Sp.init(M, 512, G_, c_); Sk.init(M, 1024, G_, c_); Sq.init(M, 768, G_, c_); G = G_; c = c_; }
    __device__ bool next(int i, Unit& u) const { long L = (long)i * G + c;
        if (L < Sp.nwg) { Sp.at(L, u); u.pn += 7; return true; } L -= Sp.nwg;
        if (L < Sk.nwg) { Sk.at(L, u); u.pn += 3; return true; } L -= Sk.nwg;
        return Sq.at(L, u); }
    __device__ __forceinline__ Desc desc(const Unit& u) const { Desc d;
        if (u.pn < 3)      { d.A = Zp + ((size_t)u.pm * 256 * INP + Z_CQ) * 2;  d.B = Wq + (size_t)u.pn * 256 * QL * 2;        d.lda = INP; d.K = QL; }
        else if (u.pn < 7) { d.A = Zp + ((size_t)u.pm * 256 * INP + Z_CKV) * 2; d.B = Wkv + (size_t)(u.pn - 3) * 256 * KVL * 2; d.lda = INP; d.K = KVL; }
        else               { d.A = DIFFp + ((size_t)u.pm * 256 * 512 + (size_t)(u.pn - 7) * 256) * 2; d.B = Wp + (size_t)(u.pn - 7) * 256 * 256 * 2; d.lda = 512; d.K = 256; }
        return d; }
};
}
namespace att {
#define GAS __attribute__((address_space(1)))
using bf16x8 = __attribute__((ext_vector_type(8))) short;
using s16x4  = __attribute__((ext_vector_type(4))) short;
using f32x16 = __attribute__((ext_vector_type(16))) float;
using u32x4  = __attribute__((ext_vector_type(4))) unsigned;
typedef unsigned short bf16_t;
constexpr int NW = 8, QBLK = 32, KVBLK = 64;
constexpr size_t SHM_V = KVBLK * 128 * 2, SHM_K = KVBLK * 128 * 2, SHM_ATTN = 2 * SHM_V + 2 * SHM_K + NW * 64 * 4;
constexpr float THR = 8.f;
#define KSWZ(row, colB) ((row) * 256 + ((colB) ^ (((row) & 15) << 4)))
#define SBAR() __builtin_amdgcn_sched_barrier(0)
__device__ __forceinline__ int crow(int r, int hi) { return (r & 3) + 8 * (r >> 2) + 4 * hi; }
__device__ __forceinline__ unsigned cvtpk(float lo, float hi) { unsigned r; asm volatile("v_cvt_pk_bf16_f32 %0, %1, %2" : "=v"(r) : "v"(lo), "v"(hi)); return r; }

__device__ __forceinline__ void partialSM(f32x16& p0, f32x16& p1, float& m_reg, float& mn, float& alpha, const float C, const float thr_s) {
  float pmax = p0[0];
#pragma unroll
  for (int r = 1; r < 16; ++r) pmax = fmaxf(pmax, p0[r]);
#pragma unroll
  for (int r = 0; r < 16; ++r) pmax = fmaxf(pmax, p1[r]);
  { auto rr = __builtin_amdgcn_permlane32_swap(__float_as_uint(pmax), __float_as_uint(pmax), false, false);
    pmax = fmaxf(__uint_as_float(rr[0]), __uint_as_float(rr[1])); }
  if (__builtin_expect(__all(pmax - m_reg <= thr_s), 1)) { mn = m_reg; alpha = 1.f; }
  else { mn = fmaxf(m_reg, pmax); alpha = __builtin_amdgcn_exp2f((m_reg - mn) * C); m_reg = mn; }
  float mnC = -mn * C;
#pragma unroll
  for (int r = 0; r < 16; ++r) p0[r] = fmaf(p0[r], C, mnC);
#pragma unroll
  for (int r = 0; r < 16; ++r) p1[r] = fmaf(p1[r], C, mnC);
#pragma unroll
  for (int r = 0; r < 16; ++r) p0[r] = __builtin_amdgcn_exp2f(p0[r]);
}
__device__ __forceinline__ void finishSM(f32x16& p0, f32x16& p1, float alpha, float& l_reg, bf16x8& pa0, bf16x8& pa1, bf16x8& pa2, bf16x8& pa3) {
#pragma unroll
  for (int r = 0; r < 16; ++r) p1[r] = __builtin_amdgcn_exp2f(p1[r]);
  float ps = 0;
#pragma unroll
  for (int r = 0; r < 16; ++r) ps += p0[r];
#pragma unroll
  for (int r = 0; r < 16; ++r) ps += p1[r];
  { auto rr = __builtin_amdgcn_permlane32_swap(__float_as_uint(ps), __float_as_uint(ps), false, false);
    ps = __uint_as_float(rr[0]) + __uint_as_float(rr[1]); }
  l_reg = l_reg * alpha + ps;
#define PK4(P, BASE, OUT) do { unsigned a0 = cvtpk(P[BASE + 0], P[BASE + 1]), a1 = cvtpk(P[BASE + 2], P[BASE + 3]);   \
    unsigned b0 = cvtpk(P[BASE + 4], P[BASE + 5]), b1 = cvtpk(P[BASE + 6], P[BASE + 7]);                              \
    auto r0 = __builtin_amdgcn_permlane32_swap(a0, b0, false, false); auto r1 = __builtin_amdgcn_permlane32_swap(a1, b1, false, false); \
    u32x4 w = {r0[0], r1[0], r0[1], r1[1]}; OUT = *reinterpret_cast<bf16x8*>(&w); } while (0)
  PK4(p0, 0, pa0); PK4(p0, 8, pa1); PK4(p1, 0, pa2); PK4(p1, 8, pa3);
#undef PK4
}
template <int NQK> __device__ __forceinline__ void qkt(f32x16& p0, f32x16& p1, const char* Ks, const bf16x8* qr, int r32, int hi) {
  p0 = f32x16{}; p1 = f32x16{};
#pragma unroll
  for (int d0 = 0; d0 < NQK; ++d0) { int cb = (d0 * 16 + hi * 8) * 2;
    bf16x8 b0 = *reinterpret_cast<const bf16x8*>(Ks + KSWZ(r32, cb));
    bf16x8 b1 = *reinterpret_cast<const bf16x8*>(Ks + KSWZ(32 + r32, cb));
    p0 = __builtin_amdgcn_mfma_f32_32x32x16_bf16(b0, qr[d0], p0, 0, 0, 0);
    p1 = __builtin_amdgcn_mfma_f32_32x32x16_bf16(b1, qr[d0], p1, 0, 0, 0); }
}
__device__ __forceinline__ int v_st(int k, int c) { const int kk = (k & ~0xC) | ((k & 4) << 1) | ((k & 8) >> 1); return ((kk >> 3) * 4 + (c >> 5)) * 512 + ((kk & 7) * 32 + (c & 31)) * 2; }
__device__ __forceinline__ int v_st_acc(int k, int c) { return ((k >> 3) * 4 + (c >> 5)) * 512 + ((k & 7) * 32 + (c & 31)) * 2; }
__device__ __forceinline__ int v_rd_base(int lane) { return ((lane & 3) << 3) | (((lane >> 2) & 3) << 6) | (((lane >> 4) & 1) << 5) | (((lane >> 5) & 1) << 8); }
constexpr int v_rd_off(int d0, int ks, int half) { return d0 * 512 + ks * 4096 + half * 2048; }
template <int OFF> __device__ __forceinline__ s16x4 tr_read(int vb) {
  s16x4 r; asm volatile("ds_read_b64_tr_b16 %0, %1 offset:%2" : "=&v"(r) : "v"(vb), "i"(OFF) : "memory"); return r;
}
template <int D0> __device__ __forceinline__ void pv_one(f32x16& od, int vb, bf16x8 pa0, bf16x8 pa1, bf16x8 pa2, bf16x8 pa3) {
  const s16x4 l0 = tr_read<v_rd_off(D0, 0, 0)>(vb), h0 = tr_read<v_rd_off(D0, 0, 1)>(vb), l1 = tr_read<v_rd_off(D0, 1, 0)>(vb), h1 = tr_read<v_rd_off(D0, 1, 1)>(vb);
  const s16x4 l2 = tr_read<v_rd_off(D0, 2, 0)>(vb), h2 = tr_read<v_rd_off(D0, 2, 1)>(vb), l3 = tr_read<v_rd_off(D0, 3, 0)>(vb), h3 = tr_read<v_rd_off(D0, 3, 1)>(vb);
  asm volatile("s_waitcnt lgkmcnt(0)" ::: "memory"); SBAR();
#define PK(L, H) (bf16x8){L[0], L[1], L[2], L[3], H[0], H[1], H[2], H[3]}
  od = __builtin_amdgcn_mfma_f32_32x32x16_bf16(pa0, PK(l0, h0), od, 0, 0, 0);
  od = __builtin_amdgcn_mfma_f32_32x32x16_bf16(pa1, PK(l1, h1), od, 0, 0, 0);
  od = __builtin_amdgcn_mfma_f32_32x32x16_bf16(pa2, PK(l2, h2), od, 0, 0, 0);
  od = __builtin_amdgcn_mfma_f32_32x32x16_bf16(pa3, PK(l3, h3), od, 0, 0, 0);
#undef PK
}
template <int NDV> __device__ __forceinline__ void pv_d0(f32x16* o, int vb, bf16x8 pa0, bf16x8 pa1, bf16x8 pa2, bf16x8 pa3) {
  pv_one<0>(o[0], vb, pa0, pa1, pa2, pa3); pv_one<1>(o[1], vb, pa0, pa1, pa2, pa3);
  if constexpr (NDV == 4) { pv_one<2>(o[2], vb, pa0, pa1, pa2, pa3); pv_one<3>(o[3], vb, pa0, pa1, pa2, pa3); }
}

template <int NQK, int NDV, int ldq, int ldk, int ldv, int ldo, bool ROPE>
__device__ __forceinline__ void attn_dense_body(const bf16_t* Qb_, const bf16_t* Kh_, const bf16_t* Vh_,
                                                bf16_t* Ob_, int seq, const float scale, char* lds, const float* cs_, const float* sn_, int pos0, int tid_in) {
  const GAS bf16_t* Qb = (const GAS bf16_t*)Qb_; const GAS bf16_t* Kh = (const GAS bf16_t*)Kh_; const GAS bf16_t* Vh = (const GAS bf16_t*)Vh_; GAS bf16_t* Ob = (GAS bf16_t*)Ob_;
  const GAS float* cs = (const GAS float*)cs_; const GAS float* sn = (const GAS float*)sn_;
  int tid_ = tid_in; asm volatile("" : "+v"(tid_));
  const int tid = tid_, wid = tid >> 6, lane = tid & 63, r32 = lane & 31, hi = lane >> 5;
  char* V_lds = lds; char* K_lds = lds + 2 * SHM_V;
  float* ws = (float*)(lds + 2 * SHM_V + 2 * SHM_K) + wid * 64; float* li_l = ws; float* al_l = ws + 32;
  const float C = scale * 1.4426950408889634f, thr_s = THR / scale;
  float m_reg = -1e30f, l_reg = 0; f32x16 o[NDV]; bf16x8 qr[NQK];
#pragma unroll
  for (int d = 0; d < NDV; ++d) o[d] = f32x16{};
  const GAS bf16_t* Qw = Qb + (long)(wid * QBLK + r32) * ldq + hi * 8;
#pragma unroll
  for (int d0 = 0; d0 < NQK; ++d0) qr[d0] = *(const GAS bf16x8*)(Qw + d0 * 16);
  if constexpr (ROPE) {
    const int pos = pos0 + wid * QBLK + r32;
#pragma unroll
    for (int d0 = 4; d0 < 6; ++d0) { const int i0 = (d0 - 4) * 8 + hi * 4;
      typedef float f4v __attribute__((ext_vector_type(4))); const f4v c4 = *(const GAS f4v*)(cs + pos * 16 + i0), s4 = *(const GAS f4v*)(sn + pos * 16 + i0);
      u32x4 w = *reinterpret_cast<u32x4*>(&qr[d0]);
      { const float x1 = __uint_as_float(w.x << 16), x2 = __uint_as_float(w.x & 0xffff0000u); w.x = cvtpk(x1 * c4.x - x2 * s4.x, x2 * c4.x + x1 * s4.x); }
      { const float x1 = __uint_as_float(w.y << 16), x2 = __uint_as_float(w.y & 0xffff0000u); w.y = cvtpk(x1 * c4.y - x2 * s4.y, x2 * c4.y + x1 * s4.y); }
      { const float x1 = __uint_as_float(w.z << 16), x2 = __uint_as_float(w.z & 0xffff0000u); w.z = cvtpk(x1 * c4.z - x2 * s4.z, x2 * c4.z + x1 * s4.z); }
      { const float x1 = __uint_as_float(w.w << 16), x2 = __uint_as_float(w.w & 0xffff0000u); w.w = cvtpk(x1 * c4.w - x2 * s4.w, x2 * c4.w + x1 * s4.w); }
      qr[d0] = *reinterpret_cast<bf16x8*>(&w); }
  }
  constexpr bool MLA = (NQK == 6);
  static_assert((NQK == 8 && NDV == 4) || (NQK == 6 && NDV == 2), "staging plans exist for these two shapes");
  constexpr int NLD = MLA ? 3 : 4;
  const int sr = tid >> 4, sc = (tid & 15) * 8;
  const int c1 = 512 + (tid & 255);
  const int g0 = MLA ? (tid / 12) * ldk + (tid % 12) * 8 : sr * ldk + sc;
  const int g1 = MLA ? (c1 / 12) * ldk + (c1 % 12) * 8 : (32 + sr) * ldk + sc;
  const int g2 = MLA ? (tid >> 3) * ldv + (tid & 7) * 8 : sr * ldv + sc;
  const int g3 = (32 + sr) * ldv + sc;
  const int l0 = MLA ? KSWZ(tid / 12, (tid % 12) * 16) : KSWZ(sr, sc * 2);
  const int l1 = MLA ? KSWZ(c1 / 12, (c1 % 12) * 16) : KSWZ(32 + sr, sc * 2);
  const int l2 = MLA ? v_st(tid >> 3, (tid & 7) * 8) : v_st(sr, sc);
  const int l3 = v_st(32 + sr, sc);
  const int vb0 = (int)(uintptr_t)V_lds + v_rd_base(lane);
  bf16x8 s_a[2], s_b[2], s_c[2], s_d[2];
#define SLOAD(i, k0) do { const GAS bf16_t* kp_ = Kh + (long)(k0) * ldk; const GAS bf16_t* vp_ = Vh + (long)(k0) * ldv; \
    s_a[i] = *(const GAS bf16x8*)(kp_ + g0); s_b[i] = *(const GAS bf16x8*)(kp_ + g1); s_c[i] = *(const GAS bf16x8*)(vp_ + g2); if constexpr (!MLA) s_d[i] = *(const GAS bf16x8*)(vp_ + g3); } while (0)
#define SWRITE(b, i) do { *(bf16x8*)(K_lds + (b) * SHM_K + l0) = s_a[i]; *(bf16x8*)(K_lds + (b) * SHM_K + l1) = s_b[i]; \
    *(bf16x8*)(V_lds + (b) * SHM_V + l2) = s_c[i]; if constexpr (!MLA) *(bf16x8*)(V_lds + (b) * SHM_V + l3) = s_d[i]; } while (0)
#define SWAIT() do { if constexpr (MLA) asm volatile("s_waitcnt vmcnt(3)" ::: "memory"); else asm volatile("s_waitcnt vmcnt(4)" ::: "memory"); } while (0)
#define RESC(a) do { if (__any((a) < 1.f)) { if (hi == 0) al_l[r32] = (a); asm volatile("s_waitcnt lgkmcnt(0)" ::: "memory"); \
    _Pragma("unroll") for (int d = 0; d < NDV; ++d) _Pragma("unroll") for (int r = 0; r < 16; ++r) o[d][r] *= al_l[crow(r, hi)]; } } while (0)
  f32x16 pA0, pA1, pB0, pB1; float mnA, mnB, alA, alB; bf16x8 pa0, pa1, pa2, pa3; const int NT = seq / KVBLK;
  constexpr int SE = 0, SO = 1;
  SLOAD(SE, 0); asm volatile("s_waitcnt vmcnt(0)" ::: "memory"); SWRITE(0, SE); __syncthreads();
  qkt<NQK>(pA0, pA1, K_lds, qr, r32, hi); partialSM(pA0, pA1, m_reg, mnA, alA, C, thr_s);
  SLOAD(SO, KVBLK); SLOAD(SE, (2 < NT ? 2 : NT - 1) * KVBLK);
  SWAIT(); SWRITE(1, SO); __syncthreads();
  for (int j = 1; j + 1 < NT; j += 2) {
    SBAR(); qkt<NQK>(pB0, pB1, K_lds + SHM_K, qr, r32, hi);
    finishSM(pA0, pA1, alA, l_reg, pa0, pa1, pa2, pa3); SBAR();
    SLOAD(SO, (j + 2) * KVBLK); SBAR();
    pv_d0<NDV>(o, vb0, pa0, pa1, pa2, pa3); partialSM(pB0, pB1, m_reg, mnB, alB, C, thr_s);
    __syncthreads(); SWAIT(); SWRITE(0, SE);
    RESC(alB); __syncthreads();
    SBAR(); qkt<NQK>(pA0, pA1, K_lds, qr, r32, hi);
    finishSM(pB0, pB1, alB, l_reg, pa0, pa1, pa2, pa3); SBAR();
    SLOAD(SE, (j + 3 < NT ? j + 3 : NT - 1) * KVBLK); SBAR();
    pv_d0<NDV>(o, vb0 + (int)SHM_V, pa0, pa1, pa2, pa3); partialSM(pA0, pA1, m_reg, mnA, alA, C, thr_s);
    __syncthreads(); SWAIT(); SWRITE(1, SO);
    RESC(alA); __syncthreads();
  }
  SBAR(); qkt<NQK>(pB0, pB1, K_lds + SHM_K, qr, r32, hi);
  finishSM(pA0, pA1, alA, l_reg, pa0, pa1, pa2, pa3); SBAR();
  pv_d0<NDV>(o, vb0, pa0, pa1, pa2, pa3); partialSM(pB0, pB1, m_reg, mnB, alB, C, thr_s);
  __syncthreads(); RESC(alB);
  finishSM(pB0, pB1, alB, l_reg, pa0, pa1, pa2, pa3); SBAR();
  pv_d0<NDV>(o, vb0 + (int)SHM_V, pa0, pa1, pa2, pa3);
  if (hi == 0) li_l[r32] = l_reg; asm volatile("s_waitcnt lgkmcnt(0)" ::: "memory");
  float rli[16];
#pragma unroll
  for (int r = 0; r < 16; ++r) rli[r] = __builtin_amdgcn_rcpf(li_l[crow(r, hi)]);
  GAS bf16_t* Ow = Ob + (long)(wid * QBLK) * ldo;
#pragma unroll
  for (int r = 0; r < 16; ++r) { int orow = crow(r, hi);
#pragma unroll
    for (int d0 = 0; d0 < NDV; ++d0) { const unsigned w = cvtpk(o[d0][r] * rli[r], 0.f); Ow[(long)orow * ldo + d0 * 32 + r32] = (bf16_t)(w & 0xffffu); } }
  __syncthreads();
#undef SLOAD
#undef SWRITE
#undef SWAIT
#undef RESC
}

template <int ldq, int ldk, int ldv, int ldo>
__device__ __forceinline__ void attn_mla_body(const bf16_t* Qb_, const bf16_t* Kh_, const bf16_t* Vh_, bf16_t* Ob_, int seq, char* lds, const float* cs_, const float* sn_, int pos0, int tid_in) {
  const GAS bf16_t* Qb = (const GAS bf16_t*)Qb_; const GAS bf16_t* Kh = (const GAS bf16_t*)Kh_; const GAS bf16_t* Vh = (const GAS bf16_t*)Vh_; GAS bf16_t* Ob = (GAS bf16_t*)Ob_;
  const GAS float* cs = (const GAS float*)cs_; const GAS float* sn = (const GAS float*)sn_;
  int tid_ = tid_in; asm volatile("" : "+v"(tid_));
  const int tid = tid_, wid = tid >> 6, lane = tid & 63, r32 = lane & 31, hi = lane >> 5;
  char* V_lds = lds; char* K_lds = lds + 2 * SHM_V;
  float* ws = (float*)(lds + 2 * SHM_V + 2 * SHM_K) + wid * 64; float* li_l = ws; float* al_l = ws + 32;
  constexpr float THR2 = 11.5416f;
  float mhat = 0.f, l_reg = 0.f; f32x16 o[2]; o[0] = f32x16{}; o[1] = f32x16{}; f32x16 negm = f32x16{}; bf16x8 qr[6];
  const GAS bf16_t* Qw = Qb + (long)(wid * QBLK + r32) * ldq + hi * 8;
#pragma unroll
  for (int d0 = 0; d0 < 6; ++d0) qr[d0] = *(const GAS bf16x8*)(Qw + d0 * 16);
  { const int pos = pos0 + wid * QBLK + r32;
#pragma unroll
    for (int d0 = 4; d0 < 6; ++d0) { const int i0 = (d0 - 4) * 8 + hi * 4;
      typedef float f4v __attribute__((ext_vector_type(4))); const f4v c4 = *(const GAS f4v*)(cs + pos * 16 + i0), s4 = *(const GAS f4v*)(sn + pos * 16 + i0);
      u32x4 w = *reinterpret_cast<u32x4*>(&qr[d0]);
      { const float x1 = __uint_as_float(w.x << 16), x2 = __uint_as_float(w.x & 0xffff0000u); w.x = cvtpk(x1 * c4.x - x2 * s4.x, x2 * c4.x + x1 * s4.x); }
      { const float x1 = __uint_as_float(w.y << 16), x2 = __uint_as_float(w.y & 0xffff0000u); w.y = cvtpk(x1 * c4.y - x2 * s4.y, x2 * c4.y + x1 * s4.y); }
      { const float x1 = __uint_as_float(w.z << 16), x2 = __uint_as_float(w.z & 0xffff0000u); w.z = cvtpk(x1 * c4.z - x2 * s4.z, x2 * c4.z + x1 * s4.z); }
      { const float x1 = __uint_as_float(w.w << 16), x2 = __uint_as_float(w.w & 0xffff0000u); w.w = cvtpk(x1 * c4.w - x2 * s4.w, x2 * c4.w + x1 * s4.w); }
      qr[d0] = *reinterpret_cast<bf16x8*>(&w); } }
  const int c1 = 512 + (tid & 255);
  const int g0 = (tid / 12) * ldk + (tid % 12) * 8, g1 = (c1 / 12) * ldk + (c1 % 12) * 8, g2 = (tid >> 3) * ldv + (tid & 7) * 8;
  const int l0 = KSWZ(tid / 12, (tid % 12) * 16), l1 = KSWZ(c1 / 12, (c1 % 12) * 16), l2 = v_st_acc(tid >> 3, (tid & 7) * 8);
  const int vb0 = (int)(uintptr_t)V_lds + v_rd_base(lane);
  const int kr0 = KSWZ(r32, hi * 16), kr1 = KSWZ(32 + r32, hi * 16);
  bf16x8 s_a[2], s_b[2], s_c[2];
#define SLOAD(i, k0) do { const GAS bf16_t* kp_ = Kh + (long)(k0) * ldk; const GAS bf16_t* vp_ = Vh + (long)(k0) * ldv; \
    s_a[i] = *(const GAS bf16x8*)(kp_ + g0); s_b[i] = *(const GAS bf16x8*)(kp_ + g1); s_c[i] = *(const GAS bf16x8*)(vp_ + g2); } while (0)
#define SWRITE(b, i) do { *(bf16x8*)(K_lds + (b) * SHM_K + l0) = s_a[i]; *(bf16x8*)(K_lds + (b) * SHM_K + l1) = s_b[i]; *(bf16x8*)(V_lds + (b) * SHM_V + l2) = s_c[i]; } while (0)
#define SWAIT() asm volatile("s_waitcnt vmcnt(3)" ::: "memory")
#define KFR(Ks, d0, half) (*reinterpret_cast<const bf16x8*>((Ks) + KSWZ((half) * 32 + r32, ((d0) * 16 + hi * 8) * 2)))
#define QKT(C0, C1, Ks) do { const bf16x8 k00 = KFR(Ks, 0, 0), k01 = KFR(Ks, 0, 1), k10 = KFR(Ks, 1, 0), k11 = KFR(Ks, 1, 1), k20 = KFR(Ks, 2, 0), k21 = KFR(Ks, 2, 1), k30 = KFR(Ks, 3, 0), k31 = KFR(Ks, 3, 1); SBAR(); \
    C0 = __builtin_amdgcn_mfma_f32_32x32x16_bf16(k00, qr[0], negm, 0, 0, 0); C1 = __builtin_amdgcn_mfma_f32_32x32x16_bf16(k01, qr[0], negm, 0, 0, 0); \
    const bf16x8 k40 = KFR(Ks, 4, 0), k41 = KFR(Ks, 4, 1), k50 = KFR(Ks, 5, 0), k51 = KFR(Ks, 5, 1); \
    C0 = __builtin_amdgcn_mfma_f32_32x32x16_bf16(k10, qr[1], C0, 0, 0, 0); C1 = __builtin_amdgcn_mfma_f32_32x32x16_bf16(k11, qr[1], C1, 0, 0, 0); \
    C0 = __builtin_amdgcn_mfma_f32_32x32x16_bf16(k20, qr[2], C0, 0, 0, 0); C1 = __builtin_amdgcn_mfma_f32_32x32x16_bf16(k21, qr[2], C1, 0, 0, 0); \
    C0 = __builtin_amdgcn_mfma_f32_32x32x16_bf16(k30, qr[3], C0, 0, 0, 0); C1 = __builtin_amdgcn_mfma_f32_32x32x16_bf16(k31, qr[3], C1, 0, 0, 0); \
    C0 = __builtin_amdgcn_mfma_f32_32x32x16_bf16(k40, qr[4], C0, 0, 0, 0); C1 = __builtin_amdgcn_mfma_f32_32x32x16_bf16(k41, qr[4], C1, 0, 0, 0); \
    C0 = __builtin_amdgcn_mfma_f32_32x32x16_bf16(k50, qr[5], C0, 0, 0, 0); C1 = __builtin_amdgcn_mfma_f32_32x32x16_bf16(k51, qr[5], C1, 0, 0, 0); } while (0)
#define ROWMAX(C0, C1, rm) do { float a_ = fmaxf(fmaxf(C0[0], C0[1]), C1[0]), b_ = fmaxf(fmaxf(C0[2], C0[3]), C1[1]); a_ = fmaxf(fmaxf(a_, C1[2]), C1[3]); \
    _Pragma("unroll") for (int r = 4; r < 16; r += 4) { a_ = fmaxf(fmaxf(a_, C0[r]), C0[r + 1]); b_ = fmaxf(fmaxf(b_, C0[r + 2]), C0[r + 3]); a_ = fmaxf(fmaxf(a_, C1[r]), C1[r + 1]); b_ = fmaxf(fmaxf(b_, C1[r + 2]), C1[r + 3]); } \
    rm = fmaxf(a_, b_); auto rr_ = __builtin_amdgcn_permlane32_swap(__float_as_uint(rm), __float_as_uint(rm), false, false); rm = fmaxf(__uint_as_float(rr_[0]), __uint_as_float(rr_[1])); } while (0)
#define DECIDE(C0, C1, alpha) do { float rm_; ROWMAX(C0, C1, rm_); alpha = 1.f; \
    if (__builtin_expect(__any(rm_ > THR2), 0)) { const float dl_ = fmaxf(rm_, 0.f); mhat += dl_; \
      _Pragma("unroll") for (int r = 0; r < 16; ++r) { C0[r] -= dl_; C1[r] -= dl_; } \
      _Pragma("unroll") for (int r = 0; r < 16; ++r) negm[r] = -mhat; \
      alpha = __builtin_amdgcn_exp2f(-dl_); l_reg *= alpha; } } while (0)
#define PINP(x) asm volatile("" : "+v"(x))
#define EXP16(P) do { _Pragma("unroll") for (int r = 0; r < 16; ++r) P[r] = __builtin_amdgcn_exp2f(P[r]); } while (0)
#define PKV(L, H) (bf16x8){L[0], L[1], L[2], L[3], H[0], H[1], H[2], H[3]}
#define PV2(vb, E0, E1) do { \
    { const s16x4 l00 = tr_read<v_rd_off(0, 0, 0)>(vb), h00 = tr_read<v_rd_off(0, 0, 1)>(vb), l10 = tr_read<v_rd_off(1, 0, 0)>(vb), h10 = tr_read<v_rd_off(1, 0, 1)>(vb); \
      const s16x4 l01 = tr_read<v_rd_off(0, 1, 0)>(vb), h01 = tr_read<v_rd_off(0, 1, 1)>(vb), l11 = tr_read<v_rd_off(1, 1, 0)>(vb), h11 = tr_read<v_rd_off(1, 1, 1)>(vb); \
      asm volatile("s_waitcnt lgkmcnt(0)" ::: "memory"); SBAR(); \
      o[0] = __builtin_amdgcn_mfma_f32_32x32x16_bf16(pa0, PKV(l00, h00), o[0], 0, 0, 0); o[1] = __builtin_amdgcn_mfma_f32_32x32x16_bf16(pa0, PKV(l10, h10), o[1], 0, 0, 0); \
      o[0] = __builtin_amdgcn_mfma_f32_32x32x16_bf16(pa1, PKV(l01, h01), o[0], 0, 0, 0); o[1] = __builtin_amdgcn_mfma_f32_32x32x16_bf16(pa1, PKV(l11, h11), o[1], 0, 0, 0); } \
    EXP16(E0); PINP(E0); \
    { const s16x4 l02 = tr_read<v_rd_off(0, 2, 0)>(vb), h02 = tr_read<v_rd_off(0, 2, 1)>(vb), l12 = tr_read<v_rd_off(1, 2, 0)>(vb), h12 = tr_read<v_rd_off(1, 2, 1)>(vb); \
      const s16x4 l03 = tr_read<v_rd_off(0, 3, 0)>(vb), h03 = tr_read<v_rd_off(0, 3, 1)>(vb), l13 = tr_read<v_rd_off(1, 3, 0)>(vb), h13 = tr_read<v_rd_off(1, 3, 1)>(vb); \
      asm volatile("s_waitcnt lgkmcnt(0)" ::: "memory"); SBAR(); \
      o[0] = __builtin_amdgcn_mfma_f32_32x32x16_bf16(pa2, PKV(l02, h02), o[0], 0, 0, 0); o[1] = __builtin_amdgcn_mfma_f32_32x32x16_bf16(pa2, PKV(l12, h12), o[1], 0, 0, 0); \
      o[0] = __builtin_amdgcn_mfma_f32_32x32x16_bf16(pa3, PKV(l03, h03), o[0], 0, 0, 0); o[1] = __builtin_amdgcn_mfma_f32_32x32x16_bf16(pa3, PKV(l13, h13), o[1], 0, 0, 0); } \
    EXP16(E1); PINP(E1); PINP(o[0]); PINP(o[1]); SBAR(); } while (0)
#define SUMPACK(P0, P1) do { float ps_ = 0.f; _Pragma("unroll") for (int r = 0; r < 16; ++r) ps_ += P0[r]; _Pragma("unroll") for (int r = 0; r < 16; ++r) ps_ += P1[r]; \
    { auto rr_ = __builtin_amdgcn_permlane32_swap(__float_as_uint(ps_), __float_as_uint(ps_), false, false); ps_ = __uint_as_float(rr_[0]) + __uint_as_float(rr_[1]); } l_reg += ps_; \
    PK4(P0, 0, pa0); PK4(P0, 8, pa1); PK4(P1, 0, pa2); PK4(P1, 8, pa3); } while (0)
#define PK4(P, BASE, OUT) do { u32x4 w = {cvtpk(P[BASE + 0], P[BASE + 1]), cvtpk(P[BASE + 2], P[BASE + 3]), cvtpk(P[BASE + 4], P[BASE + 5]), cvtpk(P[BASE + 6], P[BASE + 7])}; \
    OUT = *reinterpret_cast<bf16x8*>(&w); } while (0)
#define RESC(a) do { if (__any((a) < 1.f)) { if (hi == 0) al_l[r32] = (a); asm volatile("s_waitcnt lgkmcnt(0)" ::: "memory"); \
    _Pragma("unroll") for (int d = 0; d < 2; ++d) _Pragma("unroll") for (int r = 0; r < 16; ++r) o[d][r] *= al_l[crow(r, hi)]; } } while (0)
  f32x16 pA0, pA1, pB0, pB1; float alA, alB; bf16x8 pa0, pa1, pa2, pa3; const int NT = seq / KVBLK;
  constexpr int SE = 0, SO = 1;
  SLOAD(SE, 0); asm volatile("s_waitcnt vmcnt(0)" ::: "memory"); SWRITE(0, SE); __syncthreads();
  QKT(pA0, pA1, K_lds);
  { float rm_; ROWMAX(pA0, pA1, rm_); mhat = rm_;
#pragma unroll
    for (int r = 0; r < 16; ++r) { pA0[r] -= rm_; pA1[r] -= rm_; negm[r] = -mhat; } }
  EXP16(pA0); EXP16(pA1);
#define TCL(t) (((t) < NT ? (t) : NT - 1) * KVBLK)
  SLOAD(SO, KVBLK); SLOAD(SE, TCL(2));
  SWAIT(); SWRITE(1, SO); SLOAD(SO, TCL(3)); __syncthreads();
  for (int j = 1; j + 1 < NT; j += 2) {
    SBAR(); QKT(pB0, pB1, K_lds + SHM_K); SUMPACK(pA0, pA1); SBAR();
    DECIDE(pB0, pB1, alB); SBAR();
    PV2(vb0, pB0, pB1);
    __syncthreads(); SWAIT(); SWRITE(0, SE); SLOAD(SE, TCL(j + 3));
    RESC(alB); __syncthreads();
    SBAR(); QKT(pA0, pA1, K_lds); SUMPACK(pB0, pB1); SBAR();
    DECIDE(pA0, pA1, alA); SBAR();
    PV2(vb0 + (int)SHM_V, pA0, pA1);
    __syncthreads(); SWAIT(); SWRITE(1, SO); SLOAD(SO, TCL(j + 4));
    RESC(alA); __syncthreads();
  }
  SBAR(); QKT(pB0, pB1, K_lds + SHM_K); SUMPACK(pA0, pA1); SBAR();
  DECIDE(pB0, pB1, alB); SBAR();
  PV2(vb0, pB0, pB1);
  asm volatile("s_waitcnt vmcnt(0)" ::: "memory"); __syncthreads(); RESC(alB);
  SUMPACK(pB0, pB1); SBAR();
  pv_one<0>(o[0], vb0 + (int)SHM_V, pa0, pa1, pa2, pa3); pv_one<1>(o[1], vb0 + (int)SHM_V, pa0, pa1, pa2, pa3);
  if (hi == 0) li_l[r32] = l_reg; asm volatile("s_waitcnt lgkmcnt(0)" ::: "memory");
  float rli[16];
#pragma unroll
  for (int r = 0; r < 16; ++r) rli[r] = __builtin_amdgcn_rcpf(li_l[crow(r, hi)]);
  GAS bf16_t* Ow = Ob + (long)(wid * QBLK) * ldo;
#pragma unroll
  for (int r = 0; r < 16; ++r) { int orow = crow(r, hi);
#pragma unroll
    for (int d0 = 0; d0 < 2; ++d0) { const unsigned w = cvtpk(o[d0][r] * rli[r], 0.f); Ow[(long)orow * ldo + d0 * 32 + r32] = (bf16_t)(w & 0xffffu); } }
  __syncthreads();
  (void)kr0; (void)kr1;
#undef SLOAD
#undef SWRITE
#undef SWAIT
#undef KFR
#undef QKT
#undef ROWMAX
#undef DECIDE
#undef EXP16
#undef TCL
#undef PINP
#undef PV2
#undef PKV
#undef SUMPACK
#undef PK4
#undef RESC
}

template <int ldq, int ldk, int ldv, int ldo>
__device__ __forceinline__ void attn_mla_body2(const bf16_t* Qb_, const bf16_t* Kh_, const bf16_t* Vh_, bf16_t* Ob_, int seq, char* lds, const float* cs_, const float* sn_, int pos0, int tid_in) {
  const GAS bf16_t* Qb = (const GAS bf16_t*)Qb_; const GAS bf16_t* Kh = (const GAS bf16_t*)Kh_; const GAS bf16_t* Vh = (const GAS bf16_t*)Vh_; GAS bf16_t* Ob = (GAS bf16_t*)Ob_;
  const GAS float* cs = (const GAS float*)cs_; const GAS float* sn = (const GAS float*)sn_;
  int tid_ = tid_in; asm volatile("" : "+v"(tid_));
  const int tid = tid_, wid = __builtin_amdgcn_readfirstlane(tid >> 6), lane = tid & 63, r32 = lane & 31, hi = lane >> 5;
  const int hb = wid >> 2, ht = tid & 255, dstg = 1 + hb;
  char* V_lds = lds; char* K_lds = lds + 3 * SHM_V;
  float* ws = (float*)(lds + 3 * SHM_V + 3 * SHM_K) + wid * 64; float* al_l = ws + 32;
  constexpr float THR2 = 11.5416f;
  float mhat = 0.f; f32x16 o[3]; o[0] = f32x16{}; o[1] = f32x16{}; o[2] = f32x16{}; f32x16 negm = f32x16{}; bf16x8 qr[6];
  bf16x8 ones; { const u32x4 w1 = {0x3f803f80u, 0x3f803f80u, 0x3f803f80u, 0x3f803f80u}; ones = *reinterpret_cast<const bf16x8*>(&w1); asm volatile("" : "+v"(ones)); }
  const GAS bf16_t* Qw = Qb + (long)((tid >> 6) * QBLK + r32) * ldq + hi * 8;
#pragma unroll
  for (int d0 = 0; d0 < 6; ++d0) qr[d0] = *(const GAS bf16x8*)(Qw + d0 * 16);
  { const int pos = pos0 + (tid >> 6) * QBLK + r32;
#pragma unroll
    for (int d0 = 4; d0 < 6; ++d0) { const int i0 = (d0 - 4) * 8 + hi * 4;
      typedef float f4v __attribute__((ext_vector_type(4))); const f4v c4 = *(const GAS f4v*)(cs + pos * 16 + i0), s4 = *(const GAS f4v*)(sn + pos * 16 + i0);
      u32x4 w = *reinterpret_cast<u32x4*>(&qr[d0]);
      { const float x1 = __uint_as_float(w.x << 16), x2 = __uint_as_float(w.x & 0xffff0000u); w.x = cvtpk(x1 * c4.x - x2 * s4.x, x2 * c4.x + x1 * s4.x); }
      { const float x1 = __uint_as_float(w.y << 16), x2 = __uint_as_float(w.y & 0xffff0000u); w.y = cvtpk(x1 * c4.y - x2 * s4.y, x2 * c4.y + x1 * s4.y); }
      { const float x1 = __uint_as_float(w.z << 16), x2 = __uint_as_float(w.z & 0xffff0000u); w.z = cvtpk(x1 * c4.z - x2 * s4.z, x2 * c4.z + x1 * s4.z); }
      { const float x1 = __uint_as_float(w.w << 16), x2 = __uint_as_float(w.w & 0xffff0000u); w.w = cvtpk(x1 * c4.w - x2 * s4.w, x2 * c4.w + x1 * s4.w); }
      qr[d0] = *reinterpret_cast<bf16x8*>(&w); } }
  const int kc0 = hb * 384 + ht, kc1 = hb * 384 + 256 + (ht & 127), vc = hb * 256 + ht;
  const int g0 = (kc0 / 12) * ldk + (kc0 % 12) * 8, g1 = (kc1 / 12) * ldk + (kc1 % 12) * 8, g2 = (vc >> 3) * ldv + (vc & 7) * 8;
  const int l0 = KSWZ(kc0 / 12, (kc0 % 12) * 16), l1 = KSWZ(kc1 / 12, (kc1 % 12) * 16), l2 = v_st_acc(vc >> 3, (vc & 7) * 8);
  const int vb0 = (int)(uintptr_t)V_lds + v_rd_base(lane);
  bf16x8 s_a[2], s_b[2], s_c[2];
  const int NT = seq / KVBLK;
#define TCL(t) (((t) < NT ? (t) : NT - 1) * KVBLK)
#define SLOAD(i, k0) do { const GAS bf16_t* kp_ = Kh + (long)(k0) * ldk; const GAS bf16_t* vp_ = Vh + (long)(k0) * ldv; \
    s_a[i] = *(const GAS bf16x8*)(kp_ + g0); s_b[i] = *(const GAS bf16x8*)(kp_ + g1); s_c[i] = *(const GAS bf16x8*)(vp_ + g2); } while (0)
#define SWRITE(bo, i) do { *(bf16x8*)(K_lds + (bo) + l0) = s_a[i]; *(bf16x8*)(K_lds + (bo) + l1) = s_b[i]; *(bf16x8*)(V_lds + (bo) + l2) = s_c[i]; } while (0)
#define SWAIT() asm volatile("s_waitcnt vmcnt(3)" ::: "memory")
#define KFR(Ks, d0, half) (*reinterpret_cast<const bf16x8*>((Ks) + KSWZ((half) * 32 + r32, ((d0) * 16 + hi * 8) * 2)))
#define QKT(C0, C1, Ks) do { const bf16x8 k00 = KFR(Ks, 0, 0), k01 = KFR(Ks, 0, 1), k10 = KFR(Ks, 1, 0), k11 = KFR(Ks, 1, 1), k20 = KFR(Ks, 2, 0), k21 = KFR(Ks, 2, 1), k30 = KFR(Ks, 3, 0), k31 = KFR(Ks, 3, 1); SBAR(); \
    C0 = __builtin_amdgcn_mfma_f32_32x32x16_bf16(k00, qr[0], negm, 0, 0, 0); C1 = __builtin_amdgcn_mfma_f32_32x32x16_bf16(k01, qr[0], negm, 0, 0, 0); \
    const bf16x8 k40 = KFR(Ks, 4, 0), k41 = KFR(Ks, 4, 1), k50 = KFR(Ks, 5, 0), k51 = KFR(Ks, 5, 1); \
    C0 = __builtin_amdgcn_mfma_f32_32x32x16_bf16(k10, qr[1], C0, 0, 0, 0); C1 = __builtin_amdgcn_mfma_f32_32x32x16_bf16(k11, qr[1], C1, 0, 0, 0); \
    C0 = __builtin_amdgcn_mfma_f32_32x32x16_bf16(k20, qr[2], C0, 0, 0, 0); C1 = __builtin_amdgcn_mfma_f32_32x32x16_bf16(k21, qr[2], C1, 0, 0, 0); \
    C0 = __builtin_amdgcn_mfma_f32_32x32x16_bf16(k30, qr[3], C0, 0, 0, 0); C1 = __builtin_amdgcn_mfma_f32_32x32x16_bf16(k31, qr[3], C1, 0, 0, 0); \
    C0 = __builtin_amdgcn_mfma_f32_32x32x16_bf16(k40, qr[4], C0, 0, 0, 0); C1 = __builtin_amdgcn_mfma_f32_32x32x16_bf16(k41, qr[4], C1, 0, 0, 0); \
    C0 = __builtin_amdgcn_mfma_f32_32x32x16_bf16(k50, qr[5], C0, 0, 0, 0); C1 = __builtin_amdgcn_mfma_f32_32x32x16_bf16(k51, qr[5], C1, 0, 0, 0); } while (0)
#define PKV(L, H) (bf16x8){L[0], L[1], L[2], L[3], H[0], H[1], H[2], H[3]}
#define PVALL(vb) do { \
    { const s16x4 l00 = tr_read<v_rd_off(0, 0, 0)>(vb), h00 = tr_read<v_rd_off(0, 0, 1)>(vb), l10 = tr_read<v_rd_off(1, 0, 0)>(vb), h10 = tr_read<v_rd_off(1, 0, 1)>(vb); \
      const s16x4 l01 = tr_read<v_rd_off(0, 1, 0)>(vb), h01 = tr_read<v_rd_off(0, 1, 1)>(vb), l11 = tr_read<v_rd_off(1, 1, 0)>(vb), h11 = tr_read<v_rd_off(1, 1, 1)>(vb); \
      asm volatile("s_waitcnt lgkmcnt(0)" ::: "memory"); SBAR(); \
      o[0] = __builtin_amdgcn_mfma_f32_32x32x16_bf16(pa0, PKV(l00, h00), o[0], 0, 0, 0); o[1] = __builtin_amdgcn_mfma_f32_32x32x16_bf16(pa0, PKV(l10, h10), o[1], 0, 0, 0); o[2] = __builtin_amdgcn_mfma_f32_32x32x16_bf16(pa0, ones, o[2], 0, 0, 0); \
      o[0] = __builtin_amdgcn_mfma_f32_32x32x16_bf16(pa1, PKV(l01, h01), o[0], 0, 0, 0); o[1] = __builtin_amdgcn_mfma_f32_32x32x16_bf16(pa1, PKV(l11, h11), o[1], 0, 0, 0); o[2] = __builtin_amdgcn_mfma_f32_32x32x16_bf16(pa1, ones, o[2], 0, 0, 0); } \
    { const s16x4 l02 = tr_read<v_rd_off(0, 2, 0)>(vb), h02 = tr_read<v_rd_off(0, 2, 1)>(vb), l12 = tr_read<v_rd_off(1, 2, 0)>(vb), h12 = tr_read<v_rd_off(1, 2, 1)>(vb); \
      const s16x4 l03 = tr_read<v_rd_off(0, 3, 0)>(vb), h03 = tr_read<v_rd_off(0, 3, 1)>(vb), l13 = tr_read<v_rd_off(1, 3, 0)>(vb), h13 = tr_read<v_rd_off(1, 3, 1)>(vb); \
      asm volatile("s_waitcnt lgkmcnt(0)" ::: "memory"); SBAR(); \
      o[0] = __builtin_amdgcn_mfma_f32_32x32x16_bf16(pa2, PKV(l02, h02), o[0], 0, 0, 0); o[1] = __builtin_amdgcn_mfma_f32_32x32x16_bf16(pa2, PKV(l12, h12), o[1], 0, 0, 0); o[2] = __builtin_amdgcn_mfma_f32_32x32x16_bf16(pa2, ones, o[2], 0, 0, 0); \
      o[0] = __builtin_amdgcn_mfma_f32_32x32x16_bf16(pa3, PKV(l03, h03), o[0], 0, 0, 0); o[1] = __builtin_amdgcn_mfma_f32_32x32x16_bf16(pa3, PKV(l13, h13), o[1], 0, 0, 0); o[2] = __builtin_amdgcn_mfma_f32_32x32x16_bf16(pa3, ones, o[2], 0, 0, 0); } } while (0)
#define ROWMAX(C0, C1, rm) do { float a_ = fmaxf(fmaxf(C0[0], C0[1]), C1[0]), b_ = fmaxf(fmaxf(C0[2], C0[3]), C1[1]); a_ = fmaxf(fmaxf(a_, C1[2]), C1[3]); \
    _Pragma("unroll") for (int r = 4; r < 16; r += 4) { a_ = fmaxf(fmaxf(a_, C0[r]), C0[r + 1]); b_ = fmaxf(fmaxf(b_, C0[r + 2]), C0[r + 3]); a_ = fmaxf(fmaxf(a_, C1[r]), C1[r + 1]); b_ = fmaxf(fmaxf(b_, C1[r + 2]), C1[r + 3]); } \
    rm = fmaxf(a_, b_); auto rr_ = __builtin_amdgcn_permlane32_swap(__float_as_uint(rm), __float_as_uint(rm), false, false); rm = fmaxf(__uint_as_float(rr_[0]), __uint_as_float(rr_[1])); } while (0)
#define PK4(P, BASE, OUT) do { u32x4 w = {cvtpk(P[BASE + 0], P[BASE + 1]), cvtpk(P[BASE + 2], P[BASE + 3]), cvtpk(P[BASE + 4], P[BASE + 5]), cvtpk(P[BASE + 6], P[BASE + 7])}; OUT = *reinterpret_cast<bf16x8*>(&w); } while (0)
  f32x16 C0, C1; bf16x8 pa0, pa1, pa2, pa3; s16x4 a0, a1, a2, a3;
#define VRD8(L0, H0, L1, H1, L2, H2, L3, H3, ks0, ks1, vb) do { L0 = tr_read<v_rd_off(0, ks0, 0)>(vb); H0 = tr_read<v_rd_off(0, ks0, 1)>(vb); L1 = tr_read<v_rd_off(1, ks0, 0)>(vb); H1 = tr_read<v_rd_off(1, ks0, 1)>(vb); \
    L2 = tr_read<v_rd_off(0, ks1, 0)>(vb); H2 = tr_read<v_rd_off(0, ks1, 1)>(vb); L3 = tr_read<v_rd_off(1, ks1, 0)>(vb); H3 = tr_read<v_rd_off(1, ks1, 1)>(vb); } while (0)
#define MSEG(m) do { const char* Ks_ = K_lds + bk; const int vb_ = vb0 + bvp; const bool pv_ = (m) > 0; \
    s16x4 a4, a5, a6, a7, b0, b1, b2, b3, b4, b5, b6, b7; \
    if (pv_) { a4 = tr_read<v_rd_off(0, 1, 0)>(vb_); a5 = tr_read<v_rd_off(0, 1, 1)>(vb_); a6 = tr_read<v_rd_off(1, 1, 0)>(vb_); a7 = tr_read<v_rd_off(1, 1, 1)>(vb_); } SBAR(); \
    const bf16x8 k00 = KFR(Ks_, 0, 0), k01 = KFR(Ks_, 0, 1), k10 = KFR(Ks_, 1, 0), k11 = KFR(Ks_, 1, 1); SBAR(); \
    if (pv_) { \
      o[0] = __builtin_amdgcn_mfma_f32_32x32x16_bf16(pa0, PKV(a0, a1), o[0], 0, 0, 0); o[1] = __builtin_amdgcn_mfma_f32_32x32x16_bf16(pa0, PKV(a2, a3), o[1], 0, 0, 0); o[2] = __builtin_amdgcn_mfma_f32_32x32x16_bf16(pa0, ones, o[2], 0, 0, 0); \
      asm volatile("s_waitcnt lgkmcnt(4)" ::: "memory"); SBAR(); \
      VRD8(b0, b1, b2, b3, b4, b5, b6, b7, 2, 3, vb_); \
      o[0] = __builtin_amdgcn_mfma_f32_32x32x16_bf16(pa1, PKV(a4, a5), o[0], 0, 0, 0); o[1] = __builtin_amdgcn_mfma_f32_32x32x16_bf16(pa1, PKV(a6, a7), o[1], 0, 0, 0); o[2] = __builtin_amdgcn_mfma_f32_32x32x16_bf16(pa1, ones, o[2], 0, 0, 0); } SBAR(); \
    const bf16x8 k20 = KFR(Ks_, 2, 0), k21 = KFR(Ks_, 2, 1), k30 = KFR(Ks_, 3, 0), k31 = KFR(Ks_, 3, 1); SBAR(); \
    if (pv_) { asm volatile("s_waitcnt lgkmcnt(4)" ::: "memory"); SBAR(); \
      o[0] = __builtin_amdgcn_mfma_f32_32x32x16_bf16(pa2, PKV(b0, b1), o[0], 0, 0, 0); o[1] = __builtin_amdgcn_mfma_f32_32x32x16_bf16(pa2, PKV(b2, b3), o[1], 0, 0, 0); o[2] = __builtin_amdgcn_mfma_f32_32x32x16_bf16(pa2, ones, o[2], 0, 0, 0); \
      o[0] = __builtin_amdgcn_mfma_f32_32x32x16_bf16(pa3, PKV(b4, b5), o[0], 0, 0, 0); o[1] = __builtin_amdgcn_mfma_f32_32x32x16_bf16(pa3, PKV(b6, b7), o[1], 0, 0, 0); o[2] = __builtin_amdgcn_mfma_f32_32x32x16_bf16(pa3, ones, o[2], 0, 0, 0); } SBAR(); \
    C0 = __builtin_amdgcn_mfma_f32_32x32x16_bf16(k00, qr[0], negm, 0, 0, 0); C1 = __builtin_amdgcn_mfma_f32_32x32x16_bf16(k01, qr[0], negm, 0, 0, 0); \
    const bf16x8 k40 = KFR(Ks_, 4, 0), k41 = KFR(Ks_, 4, 1), k50 = KFR(Ks_, 5, 0), k51 = KFR(Ks_, 5, 1); \
    C0 = __builtin_amdgcn_mfma_f32_32x32x16_bf16(k10, qr[1], C0, 0, 0, 0); C1 = __builtin_amdgcn_mfma_f32_32x32x16_bf16(k11, qr[1], C1, 0, 0, 0); \
    C0 = __builtin_amdgcn_mfma_f32_32x32x16_bf16(k20, qr[2], C0, 0, 0, 0); C1 = __builtin_amdgcn_mfma_f32_32x32x16_bf16(k21, qr[2], C1, 0, 0, 0); \
    C0 = __builtin_amdgcn_mfma_f32_32x32x16_bf16(k30, qr[3], C0, 0, 0, 0); C1 = __builtin_amdgcn_mfma_f32_32x32x16_bf16(k31, qr[3], C1, 0, 0, 0); \
    C0 = __builtin_amdgcn_mfma_f32_32x32x16_bf16(k40, qr[4], C0, 0, 0, 0); C1 = __builtin_amdgcn_mfma_f32_32x32x16_bf16(k41, qr[4], C1, 0, 0, 0); \
    C0 = __builtin_amdgcn_mfma_f32_32x32x16_bf16(k50, qr[5], C0, 0, 0, 0); C1 = __builtin_amdgcn_mfma_f32_32x32x16_bf16(k51, qr[5], C1, 0, 0, 0); } while (0)
#define VSEG(m, i) do { float rm_; ROWMAX(C0, C1, rm_); \
    if ((m) == 0) { mhat = rm_; _Pragma("unroll") for (int r = 0; r < 16; ++r) { C0[r] -= rm_; C1[r] -= rm_; negm[r] = -mhat; } } \
    else if (__builtin_expect(__any(rm_ > THR2), 0)) { const float dl_ = fmaxf(rm_, 0.f); mhat += dl_; \
      _Pragma("unroll") for (int r = 0; r < 16; ++r) { C0[r] -= dl_; C1[r] -= dl_; } \
      _Pragma("unroll") for (int r = 0; r < 16; ++r) negm[r] = -mhat; \
      const float al_ = __builtin_amdgcn_exp2f(-dl_); if (hi == 0) al_l[r32] = al_; asm volatile("s_waitcnt lgkmcnt(0)" ::: "memory"); \
      _Pragma("unroll") for (int d = 0; d < 3; ++d) _Pragma("unroll") for (int r = 0; r < 16; ++r) o[d][r] *= al_l[crow(r, hi)]; } \
    _Pragma("unroll") for (int r = 0; r < 16; ++r) C0[r] = __builtin_amdgcn_exp2f(C0[r]); \
    _Pragma("unroll") for (int r = 0; r < 16; ++r) C1[r] = __builtin_amdgcn_exp2f(C1[r]); \
    PK4(C0, 0, pa0); PK4(C0, 8, pa1); PK4(C1, 0, pa2); PK4(C1, 8, pa3); \
    { const int vn_ = vb0 + bk; a0 = tr_read<v_rd_off(0, 0, 0)>(vn_); a1 = tr_read<v_rd_off(0, 0, 1)>(vn_); a2 = tr_read<v_rd_off(1, 0, 0)>(vn_); a3 = tr_read<v_rd_off(1, 0, 1)>(vn_); } \
    SWAIT(); if ((m) + dstg < NT) { SWRITE(bw, i); } SLOAD(i, TCL((m) + dstg + 2)); \
    bvp = bk; bk = (bk == 2 * (int)SHM_K ? 0 : bk + (int)SHM_K); bw = (bw == 2 * (int)SHM_K ? 0 : bw + (int)SHM_K); } while (0)
  SLOAD(0, 0); SLOAD(1, TCL(1)); asm volatile("s_waitcnt vmcnt(0)" ::: "memory");
  SWRITE(0, 0); if (hb) { SWRITE((int)SHM_K, 1); }
  SLOAD(0, TCL(dstg)); SLOAD(1, TCL(dstg + 1));
  int bk = 0, bvp = 0, bw = dstg * (int)SHM_K;
  if (hb) __syncthreads();
  for (int m = 0; m < NT; m += 2) {
    __syncthreads(); __builtin_amdgcn_s_setprio(1); MSEG(m); __builtin_amdgcn_s_setprio(0);
    __syncthreads(); VSEG(m, 0);
    __syncthreads(); __builtin_amdgcn_s_setprio(1); MSEG(m + 1); __builtin_amdgcn_s_setprio(0);
    __syncthreads(); VSEG(m + 1, 1);
  }
  __syncthreads(); { PVALL(vb0 + bvp); }
  if (!hb) __syncthreads();
  asm volatile("s_waitcnt vmcnt(0)" ::: "memory");
  float rli[16];
#pragma unroll
  for (int r = 0; r < 16; ++r) rli[r] = __builtin_amdgcn_rcpf(o[2][r]);
  GAS bf16_t* Ow = Ob + (long)((tid >> 6) * QBLK) * ldo;
#pragma unroll
  for (int r = 0; r < 16; ++r) { int orow = crow(r, hi);
#pragma unroll
    for (int d0 = 0; d0 < 2; ++d0) { const unsigned w = cvtpk(o[d0][r] * rli[r], 0.f); Ow[(long)orow * ldo + d0 * 32 + r32] = (bf16_t)(w & 0xffffu); } }
  __syncthreads();
#undef TCL
#undef SLOAD
#undef SWRITE
#undef SWAIT
#undef KFR
#undef QKT
#undef PKV
#undef PVALL
#undef VRD8
#undef ROWMAX
#undef PK4
#undef MSEG
#undef VSEG
}
#undef KSWZ
#undef SBAR
}

#define LAS __attribute__((address_space(3)))
typedef unsigned short bf16_t;
typedef float f32x4 __attribute__((ext_vector_type(4)));
typedef unsigned u32x4 __attribute__((ext_vector_type(4)));
typedef unsigned u32x2 __attribute__((ext_vector_type(2)));
using pg8::cvt_pk_bf16; using pg8::bf_lo; using pg8::bf_hi;
#define LDS_WAIT() asm volatile("s_waitcnt lgkmcnt(0)" ::: "memory")

#define XB_TMO      128
#define XB_XCNT(j)  (256  + 64 * (j))
#define XB_XSUB(j)  (1280 + 64 * (j))
#define XB_XGEN(j)  (2304 + 64 * (j))
#define XB_TOP      3328
#define XB_TOPGEN   3392
#define XCD_BAR_WORDS 3456
#define XB_SPIN_CAP (1u << 18)

__device__ __forceinline__ unsigned xb_ld(unsigned* p)              { return __hip_atomic_load(p, __ATOMIC_RELAXED, __HIP_MEMORY_SCOPE_AGENT); }
__device__ __forceinline__ unsigned xb_add(unsigned* p, unsigned v) { return __hip_atomic_fetch_add(p, v, __ATOMIC_RELAXED, __HIP_MEMORY_SCOPE_AGENT); }
__device__ __forceinline__ unsigned xb_xcc_id() { return (unsigned)__builtin_amdgcn_s_getreg((3 << 11) | 20) & 0xFu; }
#define XB_SPIN(cond, bar) do { unsigned _sp = 0; while (cond) { __builtin_amdgcn_s_sleep(1); \
    if ((++_sp & 255u) == 0u) { if (xb_ld(&(bar)[XB_TMO])) break; if (_sp > XB_SPIN_CAP) { atomicAdd(&(bar)[XB_TMO], 1u); break; } } } } while (0)

struct XcdBarrier {
    unsigned* bar; unsigned x;
    volatile LAS unsigned* st;
};

__device__ __forceinline__ XcdBarrier xcd_barrier_post(unsigned* bar, volatile LAS unsigned* st) {
    XcdBarrier b; b.bar = bar; b.x = xb_xcc_id(); b.st = st;
    if (threadIdx.x == 0) (void)xb_add(&bar[XB_XCNT(b.x)], 1u);
    return b;
}
__device__ __forceinline__ void xcd_barrier_complete(unsigned* bar, unsigned x, unsigned& nloc, unsigned& nx) {
    const unsigned G = gridDim.x * gridDim.y * gridDim.z;
    unsigned sum, cnt, mine, sp = 0u;
    for (;;) {
        sum = 0u; cnt = 0u; mine = 0u;
#pragma unroll
        for (unsigned j = 0; j < 16; ++j) { const unsigned c = xb_ld(&bar[XB_XCNT(j)]); sum += c; cnt += (c > 0u) ? 1u : 0u; mine = (j == x) ? c : mine; }
        if (sum == G) break;
        __builtin_amdgcn_s_sleep(1);
        if ((++sp & 255u) == 0u) { if (xb_ld(&bar[XB_TMO])) break; if (sp > XB_SPIN_CAP) { atomicAdd(&bar[XB_TMO], 1u); break; } }
    }
    nloc = mine > 0u ? mine : 1u; nx = cnt > 0u ? cnt : 1u;
}

__device__ __forceinline__ void xcd_barrier(const XcdBarrier& b) {
    asm volatile("s_waitcnt vmcnt(0)" ::: "memory");
    __syncthreads();
    if (threadIdx.x == 0) {
        unsigned* bar = b.bar;
        __builtin_amdgcn_s_waitcnt(0);
        unsigned nloc = b.st[0], nx = b.st[1];
        if (nloc == 0u) { xcd_barrier_complete(bar, b.x, nloc, nx); b.st[0] = nloc; b.st[1] = nx; }
        const unsigned old = xb_add(&bar[XB_XSUB(b.x)], 1u);
        const unsigned gen = old / nloc;
        if (old + 1u == (gen + 1u) * nloc) {
            __builtin_amdgcn_fence(__ATOMIC_RELEASE, "agent");
            asm volatile("s_waitcnt vmcnt(0)" ::: "memory");
            const unsigned og = xb_add(&bar[XB_TOP], 1u);
            const unsigned tg = og / nx;
            if (og + 1u == (tg + 1u) * nx) xb_add(&bar[XB_TOPGEN], 1u);
            else XB_SPIN(xb_ld(&bar[XB_TOPGEN]) == tg, bar);
            xb_add(&bar[XB_XGEN(b.x)], 1u);
            __builtin_amdgcn_fence(__ATOMIC_ACQUIRE, "agent");
            asm volatile("s_waitcnt vmcnt(0)" ::: "memory");
        } else {
            XB_SPIN(xb_ld(&bar[XB_XGEN(b.x)]) == gen, bar);
            __builtin_amdgcn_fence(__ATOMIC_ACQUIRE, "agent");
            asm volatile("s_waitcnt vmcnt(0)" ::: "memory");
        }
    }
    __syncthreads();
}


struct Params { const float* in[24]; float* out; unsigned char* ws; int ph_lo, ph_hi; };
typedef const __attribute__((address_space(4))) unsigned long long* KArg;
#define PIN(i) ((const float*)ka[i])
enum { I_XP = 0, I_XS, I_MP, I_MS, I_WIN, I_QN, I_KVN, I_WUQ, I_WUK, I_WUV, I_PMIX, I_PSC, I_MEMN, I_WMEM, I_WBR, I_WGATE, I_BGATE, I_WOUT, I_LMPRE, I_LMPOST, I_LFPRE, I_LFPOST, I_WGU, I_WDOWN };

template <int M> __device__ __forceinline__ float swz_xor(float v) { return __int_as_float(__builtin_amdgcn_ds_swizzle(__float_as_int(v), (M << 10) | 0x1f)); }
__device__ __forceinline__ float wave_sum(float v) {
    v += swz_xor<1>(v); v += swz_xor<2>(v); v += swz_xor<4>(v); v += swz_xor<8>(v); v += swz_xor<16>(v);
    auto rr = __builtin_amdgcn_permlane32_swap(__float_as_uint(v), __float_as_uint(v), false, false);
    return __uint_as_float(rr[0]) + __uint_as_float(rr[1]);
}
enum { M_IN = 0, M_GATE, M_UQ, M_UKV, M_POOL, M_BR, M_OUT, M_GU, M_DOWN, M_MEM };
__device__ __forceinline__ float wval(KArg ka, int mat, int l, int k, int n) {
    switch (mat) {
    case M_IN:   return n < INW ? PIN(I_WIN)[((size_t)l * 1024 + k) * INW + n] * PIN(I_LMPRE)[l * 1024 + k] : 0.f;
    case M_GATE: return PIN(I_WGATE)[((size_t)l * 1024 + k) * 3072 + n] * PIN(I_LMPRE)[l * 1024 + k];
    case M_UQ: { const int h = n / 96, j = n % 96; const int src = j < 64 ? h * 96 + j : h * 96 + 64 + ((j - 64) >> 1) + 16 * ((j - 64) & 1);
                 return PIN(I_WUQ)[((size_t)l * QL + k) * QW + src] * PIN(I_QN)[l * QL + k] * 0.14724445f; }
    case M_UKV:  return (n < 512 ? PIN(I_WUK)[((size_t)l * KVL + k) * 512 + n] : PIN(I_WUV)[((size_t)l * KVL + k) * 512 + n - 512]) * PIN(I_KVN)[l * KVL + k];
    case M_POOL: { const int g = n >> 7, d = n & 127, gl = k >> 7, c = k & 127; return (g & 1) == gl ? PIN(I_PMIX)[(((size_t)l * 4 + g) * 128 + c) * 128 + d] * PIN(I_PSC)[l * 512 + n] : 0.f; }
    case M_BR:   { const int nb = n >> 10, d = n & 1023; return PIN(I_WBR)[(((size_t)l * 3 + nb) * 512 + k) * 1024 + d]; }
    case M_OUT:  return PIN(I_WOUT)[((size_t)l * 1024 + k) * 1024 + n];
    case M_GU:   { const int pn = n >> 8, half = (n >> 7) & 1, j = n & 127; const int src = half * DFF + pn * 128 + j; return PIN(I_WGU)[((size_t)l * 1024 + k) * 5632 + src] * PIN(I_LFPRE)[l * 1024 + k]; }
    case M_DOWN: return PIN(I_WDOWN)[((size_t)l * DFF + k) * 1024 + n];
    default:     { const int ll = n >> 10, nn = n & 1023; return PIN(I_WMEM)[((size_t)ll * 1024 + k) * 1024 + nn] * PIN(I_MEMN)[ll * 1024 + k]; }
    }
}
__device__ __forceinline__ void tr_item(KArg ka, int mat, int l, int K, bf16_t* WT, LAS float* scr, int kb, int nb, int lane) {
    const int k0 = 64 * kb, n0 = 32 * nb;
#pragma unroll 4
    for (int i = 0; i < 32; ++i) { const int kk = 2 * i + (lane >> 5); scr[kk * 33 + (lane & 31)] = wval(ka, mat, l, k0 + kk, n0 + (lane & 31)); }
    LDS_WAIT(); asm volatile("" ::: "memory");
    const int c = lane & 7;
#pragma unroll
    for (int j = 0; j < 4; ++j) { const int n = (lane >> 3) + 8 * j; const LAS float* s = scr + (8 * c) * 33 + n;
        u32x4 o; o.x = cvt_pk_bf16(s[0 * 33], s[1 * 33]); o.y = cvt_pk_bf16(s[2 * 33], s[3 * 33]); o.z = cvt_pk_bf16(s[4 * 33], s[5 * 33]); o.w = cvt_pk_bf16(s[6 * 33], s[7 * 33]);
        *(u32x4*)(WT + (size_t)(n0 + n) * K + k0 + 8 * c) = o; }
    LDS_WAIT(); asm volatile("" ::: "memory");
}
__device__ __forceinline__ void norm_rows(const float* xsrc, float* xdst, const bf16_t* Y, const float* gain, bf16_t* HN, int rows, int gw, int NGW, int lane) {
    for (int row = gw; row < rows; row += NGW) {
        const f32x4* xr = (const f32x4*)(xsrc + (size_t)row * DM) + lane;
        f32x4 v[4];
#pragma unroll
        for (int j = 0; j < 4; ++j) v[j] = xr[64 * j];
        if (Y) {
            const u32x2* yr = (const u32x2*)(Y + (size_t)row * DM) + lane; f32x4 y[4]; float ss = 0.f;
#pragma unroll
            for (int j = 0; j < 4; ++j) { const u32x2 w = yr[64 * j]; y[j] = (f32x4){bf_lo(w.x), bf_hi(w.x), bf_lo(w.y), bf_hi(w.y)}; ss += (y[j].x * y[j].x + y[j].y * y[j].y) + (y[j].z * y[j].z + y[j].w * y[j].w); }
            const float r = 1.0f / sqrtf(wave_sum(ss) * (1.f / DM) + EPS);
#pragma unroll
            for (int j = 0; j < 4; ++j) { const f32x4 g = *((const f32x4*)gain + lane + 64 * j); v[j] += y[j] * r * g; }
        }
        if (xdst) { f32x4* xo = (f32x4*)(xdst + (size_t)row * DM) + lane;
#pragma unroll
            for (int j = 0; j < 4; ++j) xo[64 * j] = v[j]; }
        if (HN) { float ss = 0.f;
#pragma unroll
            for (int j = 0; j < 4; ++j) ss += (v[j].x * v[j].x + v[j].y * v[j].y) + (v[j].z * v[j].z + v[j].w * v[j].w);
            const float r = 1.0f / sqrtf(wave_sum(ss) * (1.f / DM) + EPS);
            u32x2* o8 = (u32x2*)(HN + (size_t)row * DM) + lane;
#pragma unroll
            for (int j = 0; j < 4; ++j) { u32x2 w; w.x = cvt_pk_bf16(v[j].x * r, v[j].y * r); w.y = cvt_pk_bf16(v[j].z * r, v[j].w * r); o8[64 * j] = w; } }
    }
}

#define GASF __attribute__((address_space(1)))
__device__ __forceinline__ void resid_rows(const float* xf_, bf16_t* XB_, const bf16_t* Y_, const float* gain_, float* R_, float* outf_, int rows, int gw, int NGW, int lane) {
    u32x4 xw[2], yw[2], nxw[2], nyw[2]; f32x4 xv[4], nxv[4];
    const int last = rows - 1;
#define RR_LOAD(XW, YW, XV, r_) do { const int rr_ = (r_) < last ? (r_) : last; \
        if (xf_) { const GASF f32x4* p_ = (const GASF f32x4*)(xf_ + (size_t)rr_ * DM); XV[0] = p_[lane * 2]; XV[1] = p_[lane * 2 + 1]; XV[2] = p_[lane * 2 + 128]; XV[3] = p_[lane * 2 + 129]; } \
        else { const GASF u32x4* p_ = (const GASF u32x4*)(XB_ + (size_t)rr_ * DM); XW[0] = p_[lane]; XW[1] = p_[lane + 64]; } \
        if (Y_) { const GASF u32x4* q_ = (const GASF u32x4*)(Y_ + (size_t)rr_ * DM); YW[0] = q_[lane]; YW[1] = q_[lane + 64]; } } while (0)
    RR_LOAD(xw, yw, xv, gw);
    for (int row = gw; row < rows; row += NGW) {
        RR_LOAD(nxw, nyw, nxv, row + NGW);
        float v[16];
        if (xf_) {
#pragma unroll
            for (int j = 0; j < 2; ++j) { const f32x4 a = xv[2 * j], b = xv[2 * j + 1];
                v[8 * j + 0] = a.x; v[8 * j + 1] = a.y; v[8 * j + 2] = a.z; v[8 * j + 3] = a.w; v[8 * j + 4] = b.x; v[8 * j + 5] = b.y; v[8 * j + 6] = b.z; v[8 * j + 7] = b.w; } }
        else {
#pragma unroll
            for (int j = 0; j < 2; ++j) { const u32x4 w = xw[j];
                v[8 * j + 0] = bf_lo(w.x); v[8 * j + 1] = bf_hi(w.x); v[8 * j + 2] = bf_lo(w.y); v[8 * j + 3] = bf_hi(w.y); v[8 * j + 4] = bf_lo(w.z); v[8 * j + 5] = bf_hi(w.z); v[8 * j + 6] = bf_lo(w.w); v[8 * j + 7] = bf_hi(w.w); } }
        if (Y_) { float y[16]; float ss = 0.f;
#pragma unroll
            for (int j = 0; j < 2; ++j) { const u32x4 w = yw[j];
                y[8 * j + 0] = bf_lo(w.x); y[8 * j + 1] = bf_hi(w.x); y[8 * j + 2] = bf_lo(w.y); y[8 * j + 3] = bf_hi(w.y); y[8 * j + 4] = bf_lo(w.z); y[8 * j + 5] = bf_hi(w.z); y[8 * j + 6] = bf_lo(w.w); y[8 * j + 7] = bf_hi(w.w); }
#pragma unroll
            for (int i = 0; i < 16; ++i) ss += y[i] * y[i];
            const float r = 1.0f / sqrtf(wave_sum(ss) * (1.f / DM) + EPS);
            const GASF f32x4* gp = (const GASF f32x4*)gain_;
#pragma unroll
            for (int j = 0; j < 2; ++j) { const f32x4 a = gp[lane * 2 + 128 * j], b = gp[lane * 2 + 1 + 128 * j];
                v[8 * j + 0] += y[8 * j + 0] * r * a.x; v[8 * j + 1] += y[8 * j + 1] * r * a.y; v[8 * j + 2] += y[8 * j + 2] * r * a.z; v[8 * j + 3] += y[8 * j + 3] * r * a.w;
                v[8 * j + 4] += y[8 * j + 4] * r * b.x; v[8 * j + 5] += y[8 * j + 5] * r * b.y; v[8 * j + 6] += y[8 * j + 6] * r * b.z; v[8 * j + 7] += y[8 * j + 7] * r * b.w; } }
        if (outf_) { GASF f32x4* p = (GASF f32x4*)(outf_ + (size_t)row * DM);
#pragma unroll
            for (int j = 0; j < 2; ++j) { p[lane * 2 + 128 * j] = (f32x4){v[8 * j + 0], v[8 * j + 1], v[8 * j + 2], v[8 * j + 3]}; p[lane * 2 + 1 + 128 * j] = (f32x4){v[8 * j + 4], v[8 * j + 5], v[8 * j + 6], v[8 * j + 7]}; } }
        else { GASF u32x4* p = (GASF u32x4*)(XB_ + (size_t)row * DM); float ss = 0.f;
#pragma unroll
            for (int i = 0; i < 16; ++i) ss += v[i] * v[i];
#pragma unroll
            for (int j = 0; j < 2; ++j) { u32x4 w; w.x = cvt_pk_bf16(v[8 * j + 0], v[8 * j + 1]); w.y = cvt_pk_bf16(v[8 * j + 2], v[8 * j + 3]); w.z = cvt_pk_bf16(v[8 * j + 4], v[8 * j + 5]); w.w = cvt_pk_bf16(v[8 * j + 6], v[8 * j + 7]); p[lane + 64 * j] = w; }
            ss = wave_sum(ss);
            if (lane == 0) ((GASF float*)R_)[row] = 1.0f / sqrtf(ss * (1.f / DM) + EPS); }
        xw[0] = nxw[0]; xw[1] = nxw[1]; yw[0] = nyw[0]; yw[1] = nyw[1]; xv[0] = nxv[0]; xv[1] = nxv[1]; xv[2] = nxv[2]; xv[3] = nxv[3];
    }
#undef RR_LOAD
}
__device__ __forceinline__ void pool_rows(const bf16_t* Z_, bf16_t* DIFF_, float* RQ_, float* RKV_, bf16_t* Kb_, const float* cs_, const float* sn_, int SEQ, int gw, int NGW, int lane) {
    const GASF bf16_t* Z = (const GASF bf16_t*)Z_; GASF bf16_t* DIFF = (GASF bf16_t*)DIFF_; GASF float* RQ = (GASF float*)RQ_; GASF float* RKV = (GASF float*)RKV_; GASF bf16_t* Kb = (GASF bf16_t*)Kb_;
    const GASF float* cs = (const GASF float*)cs_; const GASF float* sn = (const GASF float*)sn_;
    const int gi = lane >> 4, half = 1 << gi, col0 = lane * 8;
#define PR_ACC(sgn, W_) do { a0 += sgn * bf_lo(W_.x); a1 += sgn * bf_hi(W_.x); a2 += sgn * bf_lo(W_.y); a3 += sgn * bf_hi(W_.y); a4 += sgn * bf_lo(W_.z); a5 += sgn * bf_hi(W_.z); a6 += sgn * bf_lo(W_.w); a7 += sgn * bf_hi(W_.w); } while (0)
    for (int blk = gw; blk < TG / 16; blk += NGW) {
        const int t0 = blk * 16, s0 = t0 & (SEQ - 1);
        const GASF bf16_t* zs = Z + (size_t)(t0 - s0) * INP + col0;
        float a0 = 0.f, a1 = 0.f, a2 = 0.f, a3 = 0.f, a4 = 0.f, a5 = 0.f, a6 = 0.f, a7 = 0.f;
#pragma unroll
        for (int dp = -8; dp < 8; ++dp) { const int p = s0 + dp; const bool ok = dp >= -half && dp < half && (unsigned)p < (unsigned)SEQ;
            const int pc = p < 0 ? 0 : (p >= SEQ ? SEQ - 1 : p); const u32x4 w = *(const GASF u32x4*)(zs + (size_t)pc * INP); const float f = ok ? 1.f : 0.f; PR_ACC(f, w); }
#pragma unroll 4
        for (int i = 0; i < 16; ++i) { const int s = s0 + i, pe = s + half, pl = s - half;
            const u32x4 wu = *(const GASF u32x4*)(zs + (size_t)s * INP);
            const u32x4 we = *(const GASF u32x4*)(zs + (size_t)(pe < SEQ ? pe : SEQ - 1) * INP);
            const u32x4 wl = *(const GASF u32x4*)(zs + (size_t)(pl >= 0 ? pl : 0) * INP);
            const int lo = pl < 0 ? 0 : pl, hi = pe > SEQ ? SEQ : pe; const float ic = 1.0f / (float)(hi - lo);
            u32x4 o; o.x = cvt_pk_bf16(a0 * ic - bf_lo(wu.x), a1 * ic - bf_hi(wu.x)); o.y = cvt_pk_bf16(a2 * ic - bf_lo(wu.y), a3 * ic - bf_hi(wu.y));
            o.z = cvt_pk_bf16(a4 * ic - bf_lo(wu.z), a5 * ic - bf_hi(wu.z)); o.w = cvt_pk_bf16(a6 * ic - bf_lo(wu.w), a7 * ic - bf_hi(wu.w));
            *(GASF u32x4*)(DIFF + (size_t)(t0 + i) * 512 + col0) = o;
            const float fe = pe < SEQ ? 1.f : 0.f, fl = pl >= 0 ? -1.f : 0.f; PR_ACC(fe, we); PR_ACC(fl, wl); }
        { const int tok = lane >> 4, sub = lane & 15;
#pragma unroll
          for (int ps = 0; ps < 4; ++ps) { const int t = t0 + ps * 4 + tok; const GASF bf16_t* zr = Z + (size_t)t * INP; float sq = 0.f, skv = 0.f;
#pragma unroll
              for (int k = 0; k < 3; ++k) { const u32x4 w = *(const GASF u32x4*)(zr + Z_CQ + sub * 24 + k * 8); float f;
                  f = bf_lo(w.x); sq += f * f; f = bf_hi(w.x); sq += f * f; f = bf_lo(w.y); sq += f * f; f = bf_hi(w.y); sq += f * f; f = bf_lo(w.z); sq += f * f; f = bf_hi(w.z); sq += f * f; f = bf_lo(w.w); sq += f * f; f = bf_hi(w.w); sq += f * f; }
#pragma unroll
              for (int k = 0; k < 2; ++k) { const u32x4 w = *(const GASF u32x4*)(zr + Z_CKV + sub * 16 + k * 8); float f;
                  f = bf_lo(w.x); skv += f * f; f = bf_hi(w.x); skv += f * f; f = bf_lo(w.y); skv += f * f; f = bf_hi(w.y); skv += f * f; f = bf_lo(w.z); skv += f * f; f = bf_hi(w.z); skv += f * f; f = bf_lo(w.w); skv += f * f; f = bf_hi(w.w); skv += f * f; }
              sq += swz_xor<1>(sq); sq += swz_xor<2>(sq); sq += swz_xor<4>(sq); sq += swz_xor<8>(sq);
              skv += swz_xor<1>(skv); skv += swz_xor<2>(skv); skv += swz_xor<4>(skv); skv += swz_xor<8>(skv);
              if (sub == 0) { RQ[t] = 1.0f / sqrtf(sq * (1.f / QL) + EPS); RKV[t] = 1.0f / sqrtf(skv * (1.f / KVL) + EPS); } }
#pragma unroll
          for (int ps = 0; ps < 4; ++ps) { const int t = t0 + ps * 4 + tok, s = t & (SEQ - 1), i = sub; const GASF bf16_t* zr = Z + (size_t)t * INP + Z_KR;
              const float x1 = __uint_as_float((unsigned)zr[i] << 16), x2 = __uint_as_float((unsigned)zr[i + 16] << 16); const float c = cs[s * 16 + i], sv = sn[s * 16 + i];
              const unsigned w = cvt_pk_bf16(x1 * c - x2 * sv, x2 * c + x1 * sv);
#pragma unroll
              for (int h = 0; h < NH; ++h) *(GASF unsigned*)(Kb + (size_t)t * QW + h * QKD + 64 + 2 * i) = w; } }
    }
#undef PR_ACC
}

__global__ void __launch_bounds__(512, 2) fwd_megakernel(Params p) {
    extern __shared__ __attribute__((aligned(16))) unsigned char lds[];
    cg::grid_group grid = cg::this_grid();
#define FRESH_TID(name) int name; { int z_ = 0; asm volatile("" : "+v"(z_)); int w_ = wave0; asm volatile("" : "+s"(w_)); name = w_ * 64 + __builtin_amdgcn_mbcnt_hi(-1, __builtin_amdgcn_mbcnt_lo(-1, z_)); }
#define PH_STATE \
    int zero_ = 0; asm volatile("" : "+v"(zero_)); const int lane = __builtin_amdgcn_mbcnt_hi(-1, __builtin_amdgcn_mbcnt_lo(-1, zero_)); \
    int wave = wave0; asm volatile("" : "+s"(wave)); const int tid = wave * 64 + lane; \
    int G = gridDim.x, bx = blockIdx.x; asm volatile("" : "+s"(G), "+s"(bx)); \
    const int vcu = (G % 8 == 0) ? (bx % 8) * (G / 8) + bx / 8 : bx; const int gw = vcu * 8 + wave, NGW = G * 8; \
    (void)lane; (void)gw; (void)NGW; (void)tid;
    LAS unsigned char* ldsl = (LAS unsigned char*)lds;
#define cs ((float*)(ws + WS_ROPE))
#define sn (cs + 8192 * 16)
#define MEMB ((bf16_t*)(ws + WS_MEMB))
#define KVMEM ((bf16_t*)(ws + WS_KVMEM))
#define WB ((bf16_t*)(ws + WS_W))
#define WMEM ((bf16_t*)(ws + WS_WMEM))
#define Z ((bf16_t*)(ws + A_Z))
#define DIFF ((bf16_t*)(ws + A_DIFF))
#define Q ((bf16_t*)(ws + A_Q))
#define BR ((bf16_t*)(ws + A_BR))
#define HID ((bf16_t*)(ws + A_HID))
#define HN ((bf16_t*)(ws + A_HN))
#define Kb ((bf16_t*)(ws + A_K))
#define Vb ((bf16_t*)(ws + A_V))
#define BRIN ((bf16_t*)(ws + A_BRIN))
#define MERGED ((bf16_t*)(ws + A_MERGED))
#define Y ((bf16_t*)(ws + A_Y))
#define RQ ((float*)(ws + A_RQ))
#define RKV (RQ + TG)
#define RX (RQ + 2 * TG)
    { volatile LAS unsigned* m_ = (volatile LAS unsigned*)((LAS unsigned char*)lds + 131072 + 320); if (threadIdx.x < 32) m_[threadIdx.x] = 0u; }
    __syncthreads();
    const XcdBarrier xbar = xcd_barrier_post((unsigned*)((unsigned char*)((KArg)__builtin_amdgcn_kernarg_segment_ptr())[25]) + 4096, (volatile LAS unsigned*)((LAS unsigned char*)lds + 131072 + 320) + 8);
    const int wave0 = __builtin_amdgcn_readfirstlane((int)threadIdx.x >> 6);
    KArg ka0 = (KArg)__builtin_amdgcn_kernarg_segment_ptr();
    const int lo = (int)(unsigned)ka0[26], hi = (int)(unsigned)(ka0[26] >> 32); int pc = 0;
#define PH_BEGIN if (pc >= lo && pc < hi) { KArg ka = ka0; asm volatile("" : "+s"(ka)); unsigned char* ws = (unsigned char*)ka[25]; PH_STATE
#define PH_END   if (pc + 1 < hi) { if (lo < 0) grid.sync(); xcd_barrier(xbar); } } ++pc;

    PH_BEGIN
    {
        LAS float* scr = (LAS float*)(ldsl + wave * 16384);
        constexpr int IT_IN = 16 * 56, IT_GATE = 16 * 96, IT_UQ = 6 * 24, IT_UKV = 4 * 32, IT_POOL = 4 * 16, IT_BR = 8 * 96, IT_OUT = 16 * 32, IT_GU = 16 * 176, IT_DOWN = 44 * 32;
        constexpr int IT_L = IT_IN + IT_GATE + IT_UQ + IT_UKV + IT_POOL + IT_BR + IT_OUT + IT_GU + IT_DOWN, IT_MEM = 16 * 128, NIT = 4 * IT_L + IT_MEM;
        for (int it = gw; it < NIT; it += NGW) {
            if (it >= 4 * IT_L) { const int r = it - 4 * IT_L; tr_item(ka, M_MEM, 0, 1024, WMEM, scr, r / 128, r % 128, lane); continue; }
            const int l = it / IT_L; int r = it % IT_L; bf16_t* wlp = WB + (size_t)l * W_LAYER;
            if (r < IT_IN)   { tr_item(ka, M_IN, l, 1024, wlp + WO_IN, scr, r / 56, r % 56, lane); continue; } r -= IT_IN;
            if (r < IT_GATE) { tr_item(ka, M_GATE, l, 1024, wlp + WO_GATE, scr, r / 96, r % 96, lane); continue; } r -= IT_GATE;
            if (r < IT_UQ)   { tr_item(ka, M_UQ, l, QL, wlp + WO_UQ, scr, r / 24, r % 24, lane); continue; } r -= IT_UQ;
            if (r < IT_UKV)  { tr_item(ka, M_UKV, l, KVL, wlp + WO_UKV, scr, r / 32, r % 32, lane); continue; } r -= IT_UKV;
            if (r < IT_POOL) { tr_item(ka, M_POOL, l, 256, wlp + WO_POOL, scr, r / 16, r % 16, lane); continue; } r -= IT_POOL;
            if (r < IT_BR)   { tr_item(ka, M_BR, l, 512, wlp + WO_BR, scr, r / 96, r % 96, lane); continue; } r -= IT_BR;
            if (r < IT_OUT)  { tr_item(ka, M_OUT, l, 1024, wlp + WO_OUT, scr, r / 32, r % 32, lane); continue; } r -= IT_OUT;
            if (r < IT_GU)   { tr_item(ka, M_GU, l, 1024, wlp + WO_GU, scr, r / 176, r % 176, lane); continue; } r -= IT_GU;
            tr_item(ka, M_DOWN, l, DFF, wlp + WO_DOWN, scr, r / 32, r % 32, lane);
        }
        for (int e = bx * 512 + tid; e < 8192 * 16; e += G * 512) {
            const int s = e >> 4, i = e & 15;
            const float inv = 1.0f / powf(10000.0f, (float)(2 * i) / 32.0f);
            const float ang = (float)s * inv;
            const double rev = (double)ang * 0.15915494309189535; const float fr = (float)(rev - rint(rev));
            cs[e] = __builtin_amdgcn_cosf(fr); sn[e] = __builtin_amdgcn_sinf(fr);
        }
        norm_rows(PIN(I_MP), nullptr, nullptr, nullptr, MEMB, 2048, gw, NGW, lane);
        norm_rows(PIN(I_MS), nullptr, nullptr, nullptr, MEMB + (size_t)2048 * DM, 4096, gw, NGW, lane);
        asm volatile("s_waitcnt vmcnt(0) lgkmcnt(0)" ::: "memory"); __syncthreads();
    }
    PH_END
    PH_BEGIN
    {
        pg8::Gemm g{MEMB, WMEM, 1024, 1024}; pg8::StaticOrder S; S.init(NMEMROWS, 4096, G, bx);
        pg8::Epi<pg8::EP_STORE> E{}; E.O = KVMEM; E.ldc = 4096;
        pg8::gemm_phase<pg8::Epi<pg8::EP_STORE>, pg8::StaticOrder, true, true>(ldsl, g, S, E, tid);
    }
    PH_END

    for (int grp = 0; grp < NGRP; ++grp) {
        const int SEQ = grp < 2 ? 8192 : 2048;
#define xin (grp < 2 ? PIN(I_XP) + (size_t)grp * TG * DM : PIN(I_XS))
#define xout ((float*)ka[24] + (size_t)grp * TG * DM)
        const int membase = grp < 2 ? grp * 4 * 256 : 2048;
        for (int l = 0; l < NL; ++l) {
#define wl (WB + (size_t)l * W_LAYER)
            PH_BEGIN
            if (l == 0) resid_rows(xin, HN, nullptr, nullptr, RX, nullptr, TG, gw, NGW, lane);
            else        resid_rows(nullptr, HN, Y, PIN(I_LFPOST) + (l - 1) * DM, RX, nullptr, TG, gw, NGW, lane);
            PH_END
            PH_BEGIN
            { pg8::Gemm g{HN, wl + WO_IN, DM, DM}; pg8::StaticOrder S; S.init(TG, INP, G, bx);
              pg8::Epi<pg8::EP_Q> E{}; E.O = Z; E.ldc = INP; E.rs = RX;
              pg8::gemm_phase<pg8::Epi<pg8::EP_Q>, pg8::StaticOrder, true, true>(ldsl, g, S, E, tid); }
            PH_END
            PH_BEGIN
            pool_rows(Z, DIFF, RQ, RKV, Kb, cs, sn, SEQ, gw, NGW, lane);
            PH_END
            PH_BEGIN
            { pg8::G2Order S; S.init(TG, G, bx); S.Zp = (const char*)Z; S.DIFFp = (const char*)DIFF; S.Wq = (const char*)(wl + WO_UQ); S.Wkv = (const char*)(wl + WO_UKV); S.Wp = (const char*)(wl + WO_POOL);
              pg8::Epi<pg8::EP_G2> E{}; E.O = Q; E.O2 = Kb; E.O3 = Vb; E.O4 = BRIN; E.rs = RQ; E.rs2 = RKV;
              pg8::gemm_phase_vk<pg8::Epi<pg8::EP_G2>, pg8::G2Order>(ldsl, S, E, tid); }
            PH_END
            PH_BEGIN
            { const int NQB = SEQ / 256, nunits = (TG / 256) * NH;
              for (int u = vcu; u < nunits; u += G) {
                  const int bh = u / NQB, qb = u % NQB, b = bh / NH, h = bh % NH; const size_t r0 = (size_t)b * SEQ;
                  att::attn_mla_body2<QW, QW, VW, 512>(Q + (r0 + (size_t)qb * 256) * QW + h * QKD, Kb + r0 * QW + h * QKD, Vb + r0 * VW + h * VD,
                                             BRIN + (size_t)TG * 512 + (r0 + (size_t)qb * 256) * 512 + h * VD, SEQ, (char*)lds, cs, sn, qb * 256, tid);
              }
              const int nmu = (TG / 256) * 4; FRESH_TID(tidm);
              for (int u = vcu; u < nmu; u += G) {
                  const int rb = u >> 2, h = u & 3; const size_t t0 = (size_t)rb * 256; const int b = (int)(t0 / SEQ);
                  const bf16_t* kv = KVMEM + (size_t)(membase + b * 256) * 4096 + l * 1024 + h * 128;
                  att::attn_dense_body<8, 4, INP, 4096, 4096, 512, false>(Z + t0 * INP + Z_QX + h * 128, kv, kv + 512,
                                             BRIN + (size_t)2 * TG * 512 + t0 * 512 + h * 128, 256, 0.08838834764831845f, (char*)lds, cs, sn, 0, tidm);
              } }
            PH_END
            PH_BEGIN
            { pg8::GBOrder S; S.init(TG, G, bx); S.XBp = (const char*)HN; S.WGp = (const char*)(wl + WO_GATE); S.BRINp = (const char*)BRIN; S.WBRp = (const char*)(wl + WO_BR); S.brin_n_stride = (size_t)TG * 512 * 2;
              pg8::Epi<pg8::EP_GATE> E{}; E.O = MERGED; E.ldc = DM; E.O2 = BR + (size_t)bx * 65536; E.O3 = (bf16_t*)(ws + A_MPART); E.rs = PIN(I_BGATE) + l * 3072; E.rs2 = RX;
              pg8::gemm_phase_vk<pg8::Epi<pg8::EP_GATE>, pg8::GBOrder>(ldsl, S, E, tid); }
            PH_END
            PH_BEGIN
            { pg8::Gemm g{MERGED, wl + WO_OUT, DM, DM}; pg8::StaticOrder S; S.init(TG, DM, G, bx);
              pg8::Epi<pg8::EP_STORE> E{}; E.O = Y; E.ldc = DM;
              pg8::gemm_phase<pg8::Epi<pg8::EP_STORE>, pg8::StaticOrder, true, true>(ldsl, g, S, E, tid); }
            PH_END
            PH_BEGIN
            resid_rows(nullptr, HN, Y, PIN(I_LMPOST) + l * DM, RX, nullptr, TG, gw, NGW, lane);
            PH_END
            PH_BEGIN
            { pg8::Gemm g{HN, wl + WO_GU, DM, DM}; pg8::StaticOrder S; S.init(TG, 5632, G, bx);
              pg8::Epi<pg8::EP_SWIGLU> E{}; E.O = HID; E.ldc = DFF; E.rs2 = RX;
              pg8::gemm_phase<pg8::Epi<pg8::EP_SWIGLU>, pg8::StaticOrder, true, true>(ldsl, g, S, E, tid); }
            PH_END
            PH_BEGIN
            { pg8::Gemm g{HID, wl + WO_DOWN, DFF, DFF}; pg8::StaticOrder S; S.init(TG, DM, G, bx);
              pg8::Epi<pg8::EP_STORE> E{}; E.O = Y; E.ldc = DM;
              pg8::gemm_phase<pg8::Epi<pg8::EP_STORE>, pg8::StaticOrder, true, true>(ldsl, g, S, E, tid); }
            PH_END
        }
        PH_BEGIN
        resid_rows(nullptr, HN, Y, PIN(I_LFPOST) + 3 * DM, nullptr, xout, TG, gw, NGW, lane);
        PH_END
    }
}

extern "C" void kernel_launch(void* const* d_in, const int* in_sizes, int n_in, void* d_out, int out_size, void* d_ws, size_t ws_size, hipStream_t stream) {
    static int grid = 0;
    if (grid == 0) {
        if (n_in != 24 || out_size != 98304 * 1024 || ws_size < WS_END) { fprintf(stderr, "kernel_launch: unexpected shapes: n_in %d out %d ws %zu (need %zu)\n", n_in, out_size, ws_size, (size_t)WS_END); grid = -1; return; }
        int dev = 0, cus = 0, per_cu = 0;
        hipGetDevice(&dev); hipDeviceGetAttribute(&cus, hipDeviceAttributeMultiprocessorCount, dev);
        if (hipFuncSetAttribute((const void*)fwd_megakernel, hipFuncAttributeMaxDynamicSharedMemorySize, LDS_BYTES) != hipSuccess) { fprintf(stderr, "kernel_launch: hipFuncSetAttribute failed\n"); grid = -1; return; }
        if (hipOccupancyMaxActiveBlocksPerMultiprocessor(&per_cu, (const void*)fwd_megakernel, 512, LDS_BYTES) != hipSuccess || per_cu < 1) { fprintf(stderr, "kernel_launch: occupancy query says %d\n", per_cu); per_cu = 1; }
        (void)hipGetLastError();
        grid = cus * per_cu;
    }
    if (grid < 0) return;
    if (hipMemsetAsync(d_ws, 0, 65536, stream) != hipSuccess) { fprintf(stderr, "kernel_launch: hipMemsetAsync failed\n"); return; }
    Params p{};
    for (int i = 0; i < 24; ++i) p.in[i] = (const float*)d_in[i];
    p.out = (float*)d_out; p.ws = (unsigned char*)d_ws; p.ph_lo = 0; p.ph_hi = 1 << 30;
    void* args[] = {&p};
    hipError_t e = hipLaunchCooperativeKernel((const void*)fwd_megakernel, dim3(grid), dim3(512), args, LDS_BYTES, stream);
    if (e != hipSuccess) fprintf(stderr, "cooperative launch failed: %s (grid %d)\n", hipGetErrorString(e), grid);
}
```
